# Optimizing an MI355X kernel written in HIP

```python
import math
import jax, jax.numpy as jnp
from jax import lax
import numpy as np

D_MODEL = 1024
BATCH = 8
SEQ = 4096
DEPTH = 2

HEAD_DIM = 64
MOBA_HEADS = 4
DIFF_HEADS = 4
DSA_HEADS = 4
DIFF_V_DIM = 2 * HEAD_DIM
IDX_HEADS = 8
IDX_DIM = 64
MOBA_BLOCK = 256
MOBA_TOPK = 3
DSA_TOPK_MAX = 256
ROPE_THETA = 10000.0
EPS = 1e-6
Q_BLOCK = 128
MOBA_Q_CHUNK = 32
D_FF = -(-8 * D_MODEL // (3 * 256)) * 256

MOBA_W = MOBA_HEADS * HEAD_DIM
DIFF_QK_W = DIFF_HEADS * 2 * HEAD_DIM
DIFF_V_W = DIFF_HEADS * DIFF_V_DIM
DSA_W = DSA_HEADS * HEAD_DIM
IDX_Q_W = IDX_HEADS * IDX_DIM
MIX_W = MOBA_W + DIFF_V_W + DSA_W
IN_COLS = 3 * MOBA_W + 2 * DIFF_QK_W + DIFF_V_W + 3 * DSA_W + IDX_Q_W + IDX_DIM + IDX_HEADS

kernel_name = "hybrid_moba_diff_dsa_block"


def rms_norm(x, g):
    xf = x.astype(jnp.float32)
    y = xf * lax.rsqrt(jnp.mean(xf * xf, axis=-1, keepdims=True) + EPS)
    return (y * g.astype(jnp.float32)).astype(x.dtype)


def rope_tables(seq, dim):
    inv = 1.0 / (ROPE_THETA ** (jnp.arange(0, dim, 2, dtype=jnp.float32) / dim))
    ang = jnp.arange(seq, dtype=jnp.float32)[:, None] * inv[None, :]
    return jnp.cos(ang), jnp.sin(ang)


def apply_rope(x, cos, sin):
    x1, x2 = jnp.split(x, 2, axis=-1)
    c = cos.astype(x.dtype)
    s = sin.astype(x.dtype)
    return jnp.concatenate([x1 * c - x2 * s, x1 * s + x2 * c], axis=-1)


def split_heads(t, n_heads):
    b, s, _ = t.shape
    return t.reshape(b, s, n_heads, -1).transpose(0, 2, 1, 3)


def merge_heads(t):
    b, h, s, d = t.shape
    return t.transpose(0, 2, 1, 3).reshape(b, s, h * d)


def moba_attention(q, k, v):
    B, H, S, D = q.shape
    nb = -(-S // MOBA_BLOCK)
    pad = nb * MOBA_BLOCK - S
    kb = jnp.pad(k, ((0, 0), (0, 0), (0, pad), (0, 0))).reshape(B, H, nb, MOBA_BLOCK, D)
    vb = jnp.pad(v, ((0, 0), (0, 0), (0, pad), (0, 0))).reshape(B, H, nb, MOBA_BLOCK, D)
    k_mean = jnp.mean(kb.astype(jnp.float32), axis=3).astype(k.dtype)
    n_sel = min(MOBA_TOPK, nb - 1)
    scale = D ** -0.5
    blk_ids = jnp.arange(nb)
    own_off = jnp.arange(MOBA_BLOCK)
    gather = jax.vmap(jax.vmap(lambda t, i: t[i]))

    def chunk(i):
        start = i * MOBA_Q_CHUNK
        qc = lax.dynamic_slice_in_dim(q, start, MOBA_Q_CHUNK, axis=2)
        qpos = start + jnp.arange(MOBA_Q_CHUNK)
        cur = start // MOBA_BLOCK
        k_own = lax.dynamic_index_in_dim(kb, cur, axis=2, keepdims=False)
        v_own = lax.dynamic_index_in_dim(vb, cur, axis=2, keepdims=False)
        own_pos = cur * MOBA_BLOCK + own_off
        s_own = jnp.einsum('bhcd,bhkd->bhck', qc, k_own).astype(jnp.float32) * scale
        s_own = jnp.where(own_pos[None, :] <= qpos[:, None], s_own, -jnp.inf)
        if n_sel == 0:
            p_own = jax.nn.softmax(s_own, axis=-1).astype(v.dtype)
            return jnp.einsum('bhck,bhkd->bhcd', p_own, v_own)
        gate = jnp.einsum('bhcd,bhnd->bhcn', qc, k_mean).astype(jnp.float32)
        gate = jnp.where(blk_ids < cur, gate, -jnp.inf)
        _, sel = lax.top_k(gate, n_sel)
        sel_ok = jnp.arange(n_sel) < cur
        k_sel = gather(kb, sel)
        v_sel = gather(vb, sel)
        s_sel = jnp.einsum('bhcd,bhcnkd->bhcnk', qc, k_sel).astype(jnp.float32) * scale
        s_sel = jnp.where(sel_ok[:, None], s_sel, -jnp.inf).reshape(B, H, MOBA_Q_CHUNK, n_sel * MOBA_BLOCK)
        p = jax.nn.softmax(jnp.concatenate([s_sel, s_own], axis=-1), axis=-1).astype(v.dtype)
        p_sel = p[..., :n_sel * MOBA_BLOCK].reshape(B, H, MOBA_Q_CHUNK, n_sel, MOBA_BLOCK)
        p_own = p[..., n_sel * MOBA_BLOCK:]
        return (jnp.einsum('bhcnk,bhcnkd->bhcd', p_sel, v_sel)
                + jnp.einsum('bhck,bhkd->bhcd', p_own, v_own))

    out = lax.map(chunk, jnp.arange(S // MOBA_Q_CHUNK))
    return out.transpose(1, 2, 0, 3, 4).reshape(B, H, S, D)


def diff_attention(q1, q2, k1, k2, v, lam):
    B, H, S, D = q1.shape
    scale = D ** -0.5
    kpos = jnp.arange(S)

    def block(i):
        start = i * Q_BLOCK
        qpos = start + jnp.arange(Q_BLOCK)
        mask = kpos[None, :] <= qpos[:, None]

        def probs(qf, kf):
            qb = lax.dynamic_slice_in_dim(qf, start, Q_BLOCK, axis=2)
            s = jnp.einsum('bhqd,bhkd->bhqk', qb, kf).astype(jnp.float32) * scale
            return jax.nn.softmax(jnp.where(mask, s, -jnp.inf), axis=-1)

        a = probs(q1, k1) - lam * probs(q2, k2)
        return jnp.einsum('bhqk,bhkv->bhqv', a.astype(v.dtype), v)

    out = lax.map(block, jnp.arange(S // Q_BLOCK))
    return out.transpose(1, 2, 0, 3, 4).reshape(B, H, S, v.shape[-1])


def dsa_attention(q, k, v, iq, ik, iw):
    B, H, S, D = q.shape
    n_top = min(DSA_TOPK_MAX, S // 4)
    scale = D ** -0.5
    kpos = jnp.arange(S)
    gather = jax.vmap(lambda t, i: t[:, i])

    def chunk(i):
        start = i * Q_BLOCK
        qpos = start + jnp.arange(Q_BLOCK)
        iqc = lax.dynamic_slice_in_dim(iq, start, Q_BLOCK, axis=2)
        iwc = lax.dynamic_slice_in_dim(iw, start, Q_BLOCK, axis=1)
        logits = jnp.einsum('bhcd,bsd->bhcs', iqc, ik).astype(jnp.float32) * (IDX_DIM ** -0.5)
        score = jnp.einsum('bch,bhcs->bcs', iwc.astype(jnp.float32), jax.nn.relu(logits))
        score = jnp.where(kpos[None, :] <= qpos[:, None], score, -jnp.inf)
        _, sel = lax.top_k(score, n_top)
        sel_ok = sel <= qpos[None, :, None]
        qc = lax.dynamic_slice_in_dim(q, start, Q_BLOCK, axis=2)
        k_sel = gather(k, sel)
        v_sel = gather(v, sel)
        s = jnp.einsum('bhcd,bhcnd->bhcn', qc, k_sel).astype(jnp.float32) * scale
        s = jnp.where(sel_ok[:, None], s, -jnp.inf)
        p = jax.nn.softmax(s, axis=-1).astype(v.dtype)
        return jnp.einsum('bhcn,bhcnd->bhcd', p, v_sel)

    out = lax.map(chunk, jnp.arange(S // Q_BLOCK))
    return out.transpose(1, 2, 0, 3, 4).reshape(B, H, S, D)


def setup_inputs(seed: int = 0) -> dict:
    key = jax.random.key(seed)
    ks = jax.random.split(key, 12)
    f32 = jnp.float32

    def nrm(k, shape, scale):
        return jax.random.normal(k, shape, f32) * scale

    return {
        "x": nrm(ks[0], (BATCH, SEQ, D_MODEL), 1.0),
        "attn_norm_g": 1.0 + nrm(ks[1], (DEPTH, D_MODEL), 0.05),
        "w_in": nrm(ks[2], (DEPTH, D_MODEL, IN_COLS), D_MODEL ** -0.5),
        "q_norm_g": 1.0 + nrm(ks[3], (DEPTH, 3, HEAD_DIM), 0.05),
        "k_norm_g": 1.0 + nrm(ks[4], (DEPTH, 3, HEAD_DIM), 0.05),
        "diff_lambda": nrm(ks[5], (DEPTH, 4, HEAD_DIM), 0.1),
        "diff_subln_g": 1.0 + nrm(ks[6], (DEPTH, DIFF_V_DIM), 0.05),
        "w_out": nrm(ks[7], (DEPTH, MIX_W, D_MODEL), MIX_W ** -0.5),
        "ffn_norm_g": 1.0 + nrm(ks[8], (DEPTH, D_MODEL), 0.05),
        "w_gate": nrm(ks[9], (DEPTH, D_MODEL, D_FF), D_MODEL ** -0.5),
        "w_up": nrm(ks[10], (DEPTH, D_MODEL, D_FF), D_MODEL ** -0.5),
        "w_down": nrm(ks[11], (DEPTH, D_FF, D_MODEL), D_FF ** -0.5),
    }


def reference(x, attn_norm_g, w_in, q_norm_g, k_norm_g, diff_lambda, diff_subln_g,
              w_out, ffn_norm_g, w_gate, w_up, w_down):
    S = x.shape[1]
    cos, sin = rope_tables(S, HEAD_DIM)
    sizes = [MOBA_W] * 3 + [DIFF_QK_W, DIFF_QK_W, DIFF_V_W] + [DSA_W] * 3 + [IDX_Q_W, IDX_DIM, IDX_HEADS]
    offsets = []
    acc = 0
    for sz in sizes[:-1]:
        acc += sz
        offsets.append(acc)

    for l in range(DEPTH):
        h = rms_norm(x, attn_norm_g[l])
        proj = h @ w_in[l]
        (mq, mk, mv, dq, dk, dv, sq, sk, sv, iq, ik, iw) = jnp.split(proj, offsets, axis=-1)
        qg, kg = q_norm_g[l], k_norm_g[l]

        def qk(t, nh, g):
            return apply_rope(rms_norm(split_heads(t, nh), g), cos, sin)

        moba = moba_attention(qk(mq, MOBA_HEADS, qg[0]), qk(mk, MOBA_HEADS, kg[0]),
                              split_heads(mv, MOBA_HEADS))

        dq_h = qk(dq, 2 * DIFF_HEADS, qg[1])
        dk_h = qk(dk, 2 * DIFF_HEADS, kg[1])
        lam_init = 0.8 - 0.6 * math.exp(-0.3 * l)
        lp = diff_lambda[l].astype(jnp.float32)
        lam = jnp.exp(jnp.sum(lp[0] * lp[1])) - jnp.exp(jnp.sum(lp[2] * lp[3])) + lam_init
        diff = diff_attention(dq_h[:, 0::2], dq_h[:, 1::2], dk_h[:, 0::2], dk_h[:, 1::2],
                              split_heads(dv, DIFF_HEADS), lam)
        diff = rms_norm(diff, diff_subln_g[l]) * (1.0 - lam_init)

        iq_h = apply_rope(split_heads(iq, IDX_HEADS), cos, sin)
        ik_r = apply_rope(ik, cos, sin)
        dsa = dsa_attention(qk(sq, DSA_HEADS, qg[2]), qk(sk, DSA_HEADS, kg[2]),
                            split_heads(sv, DSA_HEADS), iq_h, ik_r,
                            iw * (IDX_HEADS ** -0.5))

        mix = jnp.concatenate([merge_heads(moba), merge_heads(diff), merge_heads(dsa)], axis=-1)
        x = x + mix @ w_out[l]

        h2 = rms_norm(x, ffn_norm_g[l])
        x = x + (jax.nn.silu(h2 @ w_gate[l]) * (h2 @ w_up[l])) @ w_down[l]
    return x
```

```cpp
#include <hip/hip_runtime.h>
#include <hip/hip_cooperative_groups.h>
#include <cstdio>
#include <cstdint>
#include <cmath>
namespace cg = cooperative_groups;

namespace pg8 {
#define PG8_LAS __attribute__((address_space(3)))
typedef unsigned short bf16_t;
typedef short bf16x8 __attribute__((ext_vector_type(8)));
typedef float f32x4 __attribute__((ext_vector_type(4)));
typedef unsigned u32x4 __attribute__((ext_vector_type(4)));
constexpr int BM = 256, BK = 64, HALF = 128, HTB = HALF * BK * 2  , STAGE_BYTES = 8 * HTB, NXCD = 8, WGM = 8;

__host__ __device__ __forceinline__ int lds_byte(int r, int c) { const int st = (r >> 4) * 2 + (c >> 5), rr = r & 15, cc = c & 31, ob = rr * 64 + cc * 2; return st * 1024 + (ob ^ (((ob >> 9) & 1) << 5)); }
__host__ __device__ __forceinline__ void stage_rc(int b, int& R, int& C) { const int st = b / 1024, sb = b % 1024, swz = sb ^ (((sb >> 9) & 1) << 5); R = (st >> 1) * 16 + swz / 64; C = (st & 1) * 32 + (swz % 64) / 2; }
__host__ __device__ __forceinline__ int perm32(int rho) { const int n = rho >> 4, i = rho & 15; return 8 * (i >> 2) + 4 * n + (i & 3); }

struct Unit { int pm, pn; };
struct Gemm { const bf16_t* A; const bf16_t* Bt; int M, N, K; };

struct StaticOrder {
    int nM, nN, nwg, G, c;
    __host__ __device__ void init(int M, int N, int G_, int c_) { nM = M / BM; nN = N / BM; nwg = nM * nN; G = G_; c = c_; }
    __host__ __device__ bool next(int i, Unit& u) const {
        const long L = (long)i * G + c; if (L >= nwg) return false;
        int wgid = (int)L; { const int q = nwg / NXCD, r = nwg % NXCD, xcd = wgid % NXCD, off = wgid / NXCD; wgid = (xcd < r ? xcd * (q + 1) : r * (q + 1) + (xcd - r) * q) + off; }
        const int nig = WGM * nN, gid = wgid / nig, fm = gid * WGM, gsz = (nM - fm) < WGM ? (nM - fm) : WGM;
        u.pm = fm + ((wgid % nig) % gsz); u.pn = (wgid % nig) / gsz; return true;
    }
    __device__ __forceinline__ void a_ready(const Unit&) const {}
    __device__ __forceinline__ void done(const Unit&) const {}
};

__device__ __forceinline__ unsigned cvt_pk_bf16(float lo, float hi) { unsigned r; asm volatile("v_cvt_pk_bf16_f32 %0, %1, %2" : "=v"(r) : "v"(lo), "v"(hi)); return r; }
typedef float f32x2 __attribute__((ext_vector_type(2)));
template <class Epi, class Sched, bool ALIGN_EPI = false, bool SP2 = false>
__device__ __forceinline__ void gemm_phase(PG8_LAS unsigned char* lds, const Gemm g, const Sched& S, const Epi& E) {
    int tid_ = threadIdx.x; asm volatile("" : "+v"(tid_) :: "memory");
    const int tid = tid_, wid = __builtin_amdgcn_readfirstlane(tid >> 6), lane = tid & 63, wr = wid >> 2, wc = wid & 3, fr = lane & 15, fq = lane >> 4;
    const int K = g.K, nt = K / BK;
    unsigned voffA[2], voffB[2];
#pragma unroll
    for (int i = 0; i < 2; ++i) { int R, C; stage_rc(tid * 16 + i * 8192, R, C); const int Rb = Epi::PERM ? ((R & ~31) + perm32(R & 31)) : R;
        voffA[i] = (unsigned)(R * K + C) * 2u; voffB[i] = (unsigned)(Rb * K + C) * 2u; }
    const size_t kstep = (size_t)(BK * 2);
    const size_t hstep = (size_t)HALF * K * 2;
    const size_t tstep = 2 * hstep;
    const unsigned ldsw = (unsigned)wid * 1024u;
    const int aoff = lds_byte(wr * 64 + fr, fq * 8), boff = lds_byte(wc * 32 + fr, fq * 8);
#define PG8_SA(b, h) (((b) * 2 + (h)) * HTB)
#define PG8_SB(b, h) ((4 + (b) * 2 + (h)) * HTB)
#define PG8_STAGE(bufoff, gbase, voff) do { _Pragma("unroll") for (int _i = 0; _i < 2; ++_i) \
        __builtin_amdgcn_global_load_lds((const unsigned*)((const char*)(gbase) + (voff)[_i]), (PG8_LAS unsigned*)(lds + (bufoff) + ldsw + _i * 8192), 16, 0, 0); } while (0)
#define PG8_LDA(dst, b, h) do { _Pragma("unroll") for (int m = 0; m < 4; ++m) _Pragma("unroll") for (int k = 0; k < 2; ++k) dst[m][k] = *(const PG8_LAS bf16x8*)(lds + PG8_SA(b, h) + aoff + m * 2048 + k * 1024); } while (0)
#define PG8_LDB(dst, b, h) do { _Pragma("unroll") for (int n = 0; n < 2; ++n) _Pragma("unroll") for (int k = 0; k < 2; ++k) dst[n][k] = *(const PG8_LAS bf16x8*)(lds + PG8_SB(b, h) + boff + n * 2048 + k * 1024); } while (0)
#define PG8_MMA(ai, bj, At, Bt) do { __builtin_amdgcn_s_setprio(1); _Pragma("unroll") for (int m = 0; m < 4; ++m) _Pragma("unroll") for (int n = 0; n < 2; ++n) _Pragma("unroll") for (int k = 0; k < 2; ++k) \
        acc[ai][bj][m][n] = __builtin_amdgcn_mfma_f32_16x16x32_bf16(Bt[n][k], At[m][k], acc[ai][bj][m][n], 0, 0, 0); __builtin_amdgcn_s_setprio(0); } while (0)
#define PG8_WAIT_V(n) asm volatile("s_waitcnt vmcnt(" #n ")" ::: "memory")
#define PG8_WAIT_L(n) asm volatile("s_waitcnt lgkmcnt(" #n ")" ::: "memory")
#define PG8_BAR __builtin_amdgcn_s_barrier()
#define PG8_SCHED __builtin_amdgcn_sched_barrier(0)
    Unit cur, nxt; int ui = 0;
    if (!S.next(0, cur)) return;
    f32x4 acc[2][2][4][2];
#pragma unroll
    for (int a = 0; a < 2; ++a)
#pragma unroll
        for (int b = 0; b < 2; ++b)
#pragma unroll
            for (int m = 0; m < 4; ++m)
#pragma unroll
                for (int n = 0; n < 2; ++n) acc[a][b][m][n] = (f32x4){0.f, 0.f, 0.f, 0.f};
    bf16x8 At[4][2], B0[2][2], B1[2][2];
    const char* cA = (const char*)g.A + (size_t)cur.pm * tstep; const char* cB = (const char*)g.Bt + (size_t)cur.pn * tstep;
    S.a_ready(cur);
    if constexpr (SP2) {
        PG8_STAGE(PG8_SB(0, 0), cB, voffB); PG8_STAGE(PG8_SB(0, 1), cB + hstep, voffB); PG8_STAGE(PG8_SA(0, 0), cA, voffA); PG8_STAGE(PG8_SA(0, 1), cA + hstep, voffA);
        if (wr == 1) PG8_BAR;
        PG8_WAIT_V(2); PG8_BAR;
        PG8_STAGE(PG8_SB(1, 0), cB + kstep, voffB); PG8_STAGE(PG8_SA(1, 0), cA + kstep, voffA); PG8_STAGE(PG8_SB(1, 1), cB + hstep + kstep, voffB);
        PG8_WAIT_V(6); PG8_BAR;
    } else {
        PG8_STAGE(PG8_SB(0, 0), cB, voffB); PG8_STAGE(PG8_SA(0, 0), cA, voffA); PG8_STAGE(PG8_SB(0, 1), cB + hstep, voffB); PG8_STAGE(PG8_SA(0, 1), cA + hstep, voffA);
        if (wr == 1) PG8_BAR;
        PG8_WAIT_V(4); PG8_BAR;
        PG8_STAGE(PG8_SB(1, 0), cB + kstep, voffB); PG8_STAGE(PG8_SA(1, 0), cA + kstep, voffA); PG8_STAGE(PG8_SB(1, 1), cB + hstep + kstep, voffB);
        PG8_WAIT_V(6); PG8_BAR;
    }
    for (;;) {
        const bool has_next = S.next(ui + 1, nxt);
        const char* nA = has_next ? (const char*)g.A + (size_t)nxt.pm * tstep : cA; const char* nB = has_next ? (const char*)g.Bt + (size_t)nxt.pn * tstep : cB;
        for (int t = 0; t < nt; t += 2) {
            const bool last = (t == nt - 2);
            const char* a1 = cA + (size_t)(t + 1) * kstep;
            const char* a2 = last ? nA : cA + (size_t)(t + 2) * kstep; const char* b2 = last ? nB : cB + (size_t)(t + 2) * kstep;
            const char* a3 = a2 + kstep; const char* b3 = b2 + kstep;
            if (last && has_next) S.a_ready(nxt);
            if constexpr (SP2) {
            PG8_LDB(B0, 0, 0); PG8_LDB(B1, 0, 1); PG8_SCHED; PG8_LDA(At, 0, 0); PG8_STAGE(PG8_SA(1, 1), a1 + hstep, voffA);
            PG8_WAIT_V(8); PG8_WAIT_L(0); PG8_BAR; PG8_MMA(0, 0, At, B0); PG8_MMA(0, 1, At, B1); PG8_BAR; PG8_SCHED;
            PG8_LDA(At, 0, 1); PG8_STAGE(PG8_SB(0, 0), b2, voffB); PG8_STAGE(PG8_SB(0, 1), b2 + hstep, voffB); PG8_STAGE(PG8_SA(0, 0), a2, voffA);
            PG8_WAIT_V(8); PG8_WAIT_L(0); PG8_BAR; PG8_MMA(1, 0, At, B0); PG8_MMA(1, 1, At, B1); PG8_BAR; PG8_SCHED;
            PG8_LDB(B0, 1, 0); PG8_LDB(B1, 1, 1); PG8_SCHED; PG8_LDA(At, 1, 0); PG8_STAGE(PG8_SA(0, 1), a2 + hstep, voffA);
            PG8_WAIT_V(8); PG8_WAIT_L(0); PG8_BAR; PG8_MMA(0, 0, At, B0); PG8_MMA(0, 1, At, B1); PG8_BAR; PG8_SCHED;
            PG8_LDA(At, 1, 1); PG8_STAGE(PG8_SB(1, 0), b3, voffB); PG8_STAGE(PG8_SB(1, 1), b3 + hstep, voffB); PG8_STAGE(PG8_SA(1, 0), a3, voffA);
            PG8_WAIT_V(8); PG8_WAIT_L(0); PG8_BAR; PG8_MMA(1, 0, At, B0); PG8_MMA(1, 1, At, B1); PG8_BAR; PG8_SCHED;
            } else {
            PG8_LDB(B0, 0, 0); PG8_SCHED; PG8_LDA(At, 0, 0); PG8_STAGE(PG8_SA(1, 1), a1 + hstep, voffA);
            PG8_WAIT_L(8); PG8_BAR; PG8_WAIT_L(0); PG8_MMA(0, 0, At, B0); PG8_BAR; PG8_SCHED;
            PG8_LDB(B1, 0, 1); PG8_STAGE(PG8_SB(0, 0), b2, voffB);
            PG8_BAR; PG8_WAIT_L(0); PG8_MMA(0, 1, At, B1); PG8_BAR;
            PG8_LDA(At, 0, 1); PG8_STAGE(PG8_SA(0, 0), a2, voffA);
            PG8_BAR; PG8_WAIT_L(0); PG8_MMA(1, 0, At, B0); PG8_BAR; PG8_SCHED;
            PG8_STAGE(PG8_SB(0, 1), b2 + hstep, voffB);
            PG8_WAIT_V(6); PG8_BAR; PG8_MMA(1, 1, At, B1); PG8_BAR;
            PG8_LDB(B0, 1, 0); PG8_SCHED; PG8_LDA(At, 1, 0); PG8_STAGE(PG8_SA(0, 1), a2 + hstep, voffA);
            PG8_WAIT_L(8); PG8_BAR; PG8_WAIT_L(0); PG8_MMA(0, 0, At, B0); PG8_BAR; PG8_SCHED;
            PG8_LDB(B1, 1, 1); PG8_STAGE(PG8_SB(1, 0), b3, voffB);
            PG8_BAR; PG8_WAIT_L(0); PG8_MMA(0, 1, At, B1); PG8_BAR;
            PG8_LDA(At, 1, 1); PG8_STAGE(PG8_SA(1, 0), a3, voffA);
            PG8_BAR; PG8_WAIT_L(0); PG8_MMA(1, 0, At, B0); PG8_BAR; PG8_SCHED;
            PG8_STAGE(PG8_SB(1, 1), b3 + hstep, voffB);
            PG8_WAIT_V(6); PG8_BAR; PG8_MMA(1, 1, At, B1); PG8_BAR;
            }
        }
        if constexpr (ALIGN_EPI) { if (wr == 0) PG8_BAR; }
        if constexpr (!Epi::AFTER_DRAIN) { E(acc, cur, wr, wc, fr, fq); S.done(cur); }
        if (!has_next) break;
#pragma unroll
        for (int a = 0; a < 2; ++a)
#pragma unroll
            for (int b = 0; b < 2; ++b)
#pragma unroll
                for (int m = 0; m < 4; ++m)
#pragma unroll
                    for (int n = 0; n < 2; ++n) acc[a][b][m][n] = (f32x4){0.f, 0.f, 0.f, 0.f};
        cur = nxt; cA = nA; cB = nB; ++ui;
        if constexpr (ALIGN_EPI) { if (wr == 1) PG8_BAR; }
    }
    PG8_WAIT_V(0);
    if constexpr (!ALIGN_EPI) { if (wr == 0) PG8_BAR; }
    PG8_BAR;
    if constexpr (Epi::AFTER_DRAIN) { E.fused(acc, cur, wr, wc, fr, fq, lds, wid, lane); S.done(cur); }
#undef PG8_SA
#undef PG8_SB
#undef PG8_STAGE
#undef PG8_LDA
#undef PG8_LDB
#undef PG8_MMA
#undef PG8_WAIT_V
#undef PG8_WAIT_L
#undef PG8_BAR
#undef PG8_SCHED
}
}

#ifndef PH_MASK
#define PH_MASK 255
#endif
#ifndef REP_SKIP_DIFF
#define REP_SKIP_DIFF 1
#endif
#ifndef SEL_REP_SCORE
#define SEL_REP_SCORE 1
#endif
#ifndef SEL_REP_ROWS
#define SEL_REP_ROWS 1
#endif
#ifndef EXTRA_SYNCS
#define EXTRA_SYNCS 0
#endif
#ifndef PROBE_XATOM
#define PROBE_XATOM 0
#endif
#ifndef REP_MASK
#define REP_MASK 0
#endif
#ifndef ONE_LAUNCH
#define ONE_LAUNCH 1
#endif
typedef unsigned short bf16_t;
typedef short bf16x8 __attribute__((ext_vector_type(8)));
typedef short s16x4 __attribute__((ext_vector_type(4)));
typedef float f32x4 __attribute__((ext_vector_type(4)));
typedef float f32x16 __attribute__((ext_vector_type(16)));
typedef unsigned u32x4 __attribute__((ext_vector_type(4)));
typedef unsigned u32x2 __attribute__((ext_vector_type(2)));
typedef __bf16 bf16x2_t __attribute__((ext_vector_type(2)));
typedef float f32x2_t __attribute__((ext_vector_type(2)));
typedef unsigned long long u64;
#define DI __device__ __forceinline__
#define LAS __attribute__((address_space(3)))
#define GAS __attribute__((address_space(1)))
#define MFMA32(a, b, c) __builtin_amdgcn_mfma_f32_32x32x16_bf16((a), (b), (c), 0, 0, 0)
#define NEG_INF (-__builtin_inff())

constexpr int SEQ = 4096, BATCH = 8, DM = 1024, MTOK = BATCH * SEQ, DFF = 2816, INC = 3656;
constexpr int N1A = 2816;
constexpr int NSLOT = 41;
constexpr float EPS = 1e-6f;
constexpr size_t MiB = 1u << 20;
constexpr size_t WS_CTL = 0, CTL_BYTES = 1 * MiB;
constexpr int CW_BAR = 4096;
constexpr size_t WS_KMEAN = 65536;
constexpr size_t WS_RSS = 512 * 1024;
constexpr size_t WS_CS = 1 * MiB;
constexpr size_t WS_IW = 2 * MiB;
constexpr size_t WS_W1A = 4 * MiB, WS_W1B = 15 * MiB, WS_WO = 19 * MiB, WS_W3 = 23 * MiB, WS_WD = 45 * MiB;
constexpr size_t WS_BM = 56 * MiB;
constexpr size_t WS_XB = 72 * MiB;
constexpr size_t WS_QK = 136 * MiB;
constexpr size_t WS_VT = 300 * MiB;
constexpr size_t WS_H = 136 * MiB;
constexpr size_t WS_SCR = 364 * MiB;
constexpr size_t WS_END = 492 * MiB;
constexpr int LDS_BYTES = 147456;

DI unsigned pk2(float lo, float hi) { f32x2_t v = {lo, hi}; bf16x2_t b = __builtin_convertvector(v, bf16x2_t); return __builtin_bit_cast(unsigned, b); }
DI float bf_lo(unsigned u) { return __builtin_bit_cast(float, u << 16); }
DI float bf_hi(unsigned u) { return __builtin_bit_cast(float, u & 0xffff0000u); }
DI int opaque_tid() { int t = threadIdx.x; asm volatile("" : "+v"(t)); return t; }
template <class T> DI T* gp(T* p) { return (T*)(__attribute__((address_space(1))) T*)p; }
DI int crow(int r, int h) { return (r & 3) + 8 * (r >> 2) + 4 * h; }
DI float shx(float v, int m, int lane) { return __builtin_bit_cast(float, __builtin_amdgcn_ds_bpermute((lane ^ m) << 2, __builtin_bit_cast(int, v))); }
DI float wave_sum(float v, int lane) {
#pragma unroll
    for (int o = 1; o < 64; o <<= 1) v += shx(v, o, lane);
    return v;
}

struct Params {
    const float* x; const float* attn_g; const float* w_in; const float* qg; const float* kg; const float* dlam; const float* subln;
    const float* w_out; const float* ffn_g; const float* w_gate; const float* w_up; const float* w_down;
    float* out; unsigned char* ws;
    int ph_lo, ph_hi;
};

struct EpiQK {
    static constexpr bool PERM = true, AFTER_DRAIN = false;
    bf16_t* QK; float* iw; const float* cs; const float* qg; const float* kg; const float* rss;
    DI void head(const pg8::f32x4 (&acc)[2][2][4][2], int row0, int fq, int lane, const float* g, bf16_t* dst) const {
        const bool norm = (g != nullptr);
        f32x4 g00 = {1.f, 1.f, 1.f, 1.f}, g01 = g00, g10 = g00, g11 = g00;
        if (norm) { g00 = *(const f32x4*)(g + 8 * fq); g01 = *(const f32x4*)(g + 8 * fq + 4); g10 = *(const f32x4*)(g + 32 + 8 * fq); g11 = *(const f32x4*)(g + 32 + 8 * fq + 4); }
        f32x4 nc0, nc1, ns0, ns1; float nrs;
        { const int row = row0, pos = row & (SEQ - 1); const float* cp = cs + (size_t)pos * 64 + 8 * fq;
          nc0 = *(const f32x4*)(cp); nc1 = *(const f32x4*)(cp + 4); ns0 = *(const f32x4*)(cp + 32); ns1 = *(const f32x4*)(cp + 36); nrs = rss[row]; }
#pragma unroll
        for (int idx = 0; idx < 8; ++idx) {
                const int ai = idx >> 2, m = idx & 3;
                const int row = row0 + ai * 128 + m * 16;
                const f32x4 c0 = nc0, c1 = nc1, s0 = ns0, s1 = ns1; const float rsv = nrs;
                if (idx < 7) { const int nrow = row0 + ((idx + 1) >> 2) * 128 + ((idx + 1) & 3) * 16, npos = nrow & (SEQ - 1); const float* cp = cs + (size_t)npos * 64 + 8 * fq;
                    nc0 = *(const f32x4*)(cp); nc1 = *(const f32x4*)(cp + 4); ns0 = *(const f32x4*)(cp + 32); ns1 = *(const f32x4*)(cp + 36); nrs = rss[nrow]; }
                const float rr = rsqrtf(rsv * (1.f / DM) + EPS);
                f32x4 a00 = acc[ai][0][m][0] * rr, a01 = acc[ai][0][m][1] * rr, a10 = acc[ai][1][m][0] * rr, a11 = acc[ai][1][m][1] * rr;
                {
                    f32x4 sq = a00 * a00 + a01 * a01 + a10 * a10 + a11 * a11;
                    float ss = (sq[0] + sq[1]) + (sq[2] + sq[3]);
                    ss += shx(ss, 16, lane); ss += shx(ss, 32, lane);
                    const float rn = norm ? rsqrtf(ss * (1.f / 64.f) + EPS) : 1.f;
                    a00 = a00 * rn * g00; a01 = a01 * rn * g01; a10 = a10 * rn * g10; a11 = a11 * rn * g11;
                }
                const f32x4 o00 = a00 * c0 - a10 * s0, o01 = a01 * c1 - a11 * s1, o10 = a00 * s0 + a10 * c0, o11 = a01 * s1 + a11 * c1;
                u32x4 w0, w1;
                w0[0] = pk2(o00[0], o00[1]); w0[1] = pk2(o00[2], o00[3]); w0[2] = pk2(o01[0], o01[1]); w0[3] = pk2(o01[2], o01[3]);
                w1[0] = pk2(o10[0], o10[1]); w1[1] = pk2(o10[2], o10[3]); w1[2] = pk2(o11[0], o11[1]); w1[3] = pk2(o11[2], o11[3]);
                bf16_t* dp = dst + (size_t)row * 64 + 8 * fq;
                *(u32x4*)dp = w0; *(u32x4*)(dp + 32) = w1;
                if (idx & 1) __builtin_amdgcn_sched_barrier(0);
        }
    }
    DI void operator()(const pg8::f32x4 (&acc)[2][2][4][2], const pg8::Unit& u, int wr, int wc, int fr, int fq) const {
        const int T = u.pn, row0 = u.pm * 256 + wr * 64 + fr;
        if (T == 10 && wc == 1) {
            if (fq == 0) {
#pragma unroll
                for (int ai = 0; ai < 2; ++ai)
#pragma unroll
                    for (int m = 0; m < 4; ++m) {
                        const int row = row0 + ai * 128 + m * 16;
                        const float sc = 0.35355339059f * 0.125f * rsqrtf(rss[row] * (1.f / DM) + EPS);
                        f32x4 a = acc[ai][0][m][0], b = acc[ai][0][m][1];
                        *(f32x4*)(iw + (size_t)row * 8) = a * sc; *(f32x4*)(iw + (size_t)row * 8 + 4) = b * sc;
                    }
            }
            return;
        }
        if (T == 10 && wc > 1) return;
        const int slot = (T == 10) ? 40 : T * 4 + wc;
        const float* g = (T == 0) ? qg : (T == 1) ? kg : (T <= 3) ? qg + 64 : (T <= 5) ? kg + 64 : (T == 6) ? qg + 128 : (T == 7) ? kg + 128 : nullptr;
        head(acc, row0, fq, fr + 16 * fq, g, QK + (size_t)slot * MTOK * 64);
    }
};
struct EpiVT {
    static constexpr bool PERM = true, AFTER_DRAIN = false;
    bf16_t* O; int ldc; const float* rss;
    DI void operator()(const pg8::f32x4 (&acc)[2][2][4][2], const pg8::Unit& u, int wr, int wc, int fr, int fq) const {
        const int row0 = u.pm * 256 + wr * 64 + fr, col0 = u.pn * 256 + wc * 32 + 8 * fq;
        f32x4 r0[2], r1[2];
#pragma unroll
        for (int bj = 0; bj < 2; ++bj) { const f32x4 s0 = *(const f32x4*)(rss + col0 + bj * 128), s1 = *(const f32x4*)(rss + col0 + bj * 128 + 4);
#pragma unroll
            for (int e = 0; e < 4; ++e) { r0[bj][e] = rsqrtf(s0[e] * (1.f / DM) + EPS); r1[bj][e] = rsqrtf(s1[e] * (1.f / DM) + EPS); } }
#pragma unroll
        for (int ai = 0; ai < 2; ++ai)
#pragma unroll
            for (int m = 0; m < 4; ++m) {
                bf16_t* rp = O + (size_t)(row0 + ai * 128 + m * 16) * ldc + col0;
#pragma unroll
                for (int bj = 0; bj < 2; ++bj) {
                    const f32x4 v0 = acc[ai][bj][m][0] * r0[bj], v1 = acc[ai][bj][m][1] * r1[bj];
                    u32x4 w; w[0] = pk2(v0[0], v0[1]); w[1] = pk2(v0[2], v0[3]); w[2] = pk2(v1[0], v1[1]); w[3] = pk2(v1[2], v1[3]);
                    *(u32x4*)(rp + bj * 128) = w;
                }
            }
    }
};
struct EpiRes {
    static constexpr bool PERM = true, AFTER_DRAIN = false;
    const float* srcf; const bf16_t* srcb; float* out; bf16_t* xb; float* rss;
    DI void operator()(const pg8::f32x4 (&acc)[2][2][4][2], const pg8::Unit& u, int wr, int wc, int fr, int fq) const {
        const int row0 = u.pm * 256 + wr * 64 + fr, col0 = u.pn * 256 + wc * 32 + 8 * fq, lane = fr + 16 * fq;
#pragma unroll
        for (int ai = 0; ai < 2; ++ai)
#pragma unroll
            for (int m = 0; m < 4; ++m) {
                const int row = row0 + ai * 128 + m * 16;
                const size_t off = (size_t)row * DM + col0;
                float ss = 0.f;
#pragma unroll
                for (int bj = 0; bj < 2; ++bj) {
                    f32x4 x0, x1;
                    if (srcb) { const u32x4 w = *(const u32x4*)(srcb + off + bj * 128);
                        x0 = (f32x4){bf_lo(w[0]), bf_hi(w[0]), bf_lo(w[1]), bf_hi(w[1])}; x1 = (f32x4){bf_lo(w[2]), bf_hi(w[2]), bf_lo(w[3]), bf_hi(w[3])}; }
                    else { x0 = *(const f32x4*)(srcf + off + bj * 128); x1 = *(const f32x4*)(srcf + off + bj * 128 + 4); }
                    x0 = x0 + acc[ai][bj][m][0]; x1 = x1 + acc[ai][bj][m][1];
                    if (out) { *(f32x4*)(out + off + bj * 128) = x0; *(f32x4*)(out + off + bj * 128 + 4) = x1; }
                    if (xb) { u32x4 w; w[0] = pk2(x0[0], x0[1]); w[1] = pk2(x0[2], x0[3]); w[2] = pk2(x1[0], x1[1]); w[3] = pk2(x1[2], x1[3]); *(u32x4*)(xb + off + bj * 128) = w; }
                    const f32x4 sq = x0 * x0 + x1 * x1; ss += (sq[0] + sq[1]) + (sq[2] + sq[3]);
                }
                if (rss) { ss += shx(ss, 16, lane); ss += shx(ss, 32, lane); if (fq == 0) atomicAdd(rss + row, ss); }
            }
    }
};
struct EpiSwi {
    static constexpr bool PERM = true, AFTER_DRAIN = false;
    bf16_t* H; const float* rss;
    DI void operator()(const pg8::f32x4 (&acc)[2][2][4][2], const pg8::Unit& u, int wr, int wc, int fr, int fq) const {
        const int row0 = u.pm * 256 + wr * 64 + fr, col0 = u.pn * 128 + wc * 32 + 8 * fq;
        float rsv[8];
#pragma unroll
        for (int e = 0; e < 8; ++e) rsv[e] = rss[row0 + (e >> 2) * 128 + (e & 3) * 16];
#pragma unroll
        for (int ai = 0; ai < 2; ++ai)
#pragma unroll
            for (int m = 0; m < 4; ++m) {
                float hv[8];
                const float rr = rsqrtf(rsv[4 * ai + m] * (1.f / DM) + EPS);
#pragma unroll
                for (int n = 0; n < 2; ++n)
#pragma unroll
                    for (int j = 0; j < 4; ++j) {
                        const float g = acc[ai][0][m][n][j] * rr, up = acc[ai][1][m][n][j] * rr;
                        hv[4 * n + j] = g * up * __builtin_amdgcn_rcpf(1.f + __builtin_amdgcn_exp2f(-1.44269504089f * g));
                    }
                u32x4 w; w[0] = pk2(hv[0], hv[1]); w[1] = pk2(hv[2], hv[3]); w[2] = pk2(hv[4], hv[5]); w[3] = pk2(hv[6], hv[7]);
                *(u32x4*)(H + (size_t)(row0 + ai * 128 + m * 16) * DFF + col0) = w;
            }
    }
};

DI void wconv_item(const float* W, int N, int col0, int nvalid, const float* gk, bf16_t* WT, int K, int n0, int k0, LAS float* scr, int lane) {
    const int c = lane & 31;
    const int cc = (c < nvalid) ? c : 0;
    float wv[32], gv[32];
#pragma unroll
    for (int i = 0; i < 32; ++i) { const int kk = 2 * i + (lane >> 5); wv[i] = W[(size_t)(k0 + kk) * N + col0 + cc]; gv[i] = gk ? gk[k0 + kk] : 1.f; }
#pragma unroll
    for (int i = 0; i < 32; ++i) { const int kk = 2 * i + (lane >> 5); scr[kk * 33 + c] = (c < nvalid) ? wv[i] * gv[i] : 0.f; }
    asm volatile("s_waitcnt lgkmcnt(0)" ::: "memory");
    const int ch = lane & 7;
#pragma unroll
    for (int j = 0; j < 4; ++j) {
        const int n = (lane >> 3) + 8 * j; const LAS float* s = scr + (8 * ch) * 33 + n;
        u32x4 o; o[0] = pk2(s[0], s[33]); o[1] = pk2(s[2 * 33], s[3 * 33]); o[2] = pk2(s[4 * 33], s[5 * 33]); o[3] = pk2(s[6 * 33], s[7 * 33]);
        *(u32x4*)(WT + (size_t)(n0 + n) * K + k0 + 8 * ch) = o;
    }
    asm volatile("s_waitcnt lgkmcnt(0)" ::: "memory");
}
DI void map_w1a(int n0, int& col0, int& nvalid) {
    const int T = n0 >> 8, c = n0 & 255, bj = c >> 7, wc = (c >> 5) & 3, d0 = 32 * bj;
    nvalid = 32;
    if (T == 10) { if (wc == 0) col0 = 3584 + d0; else if (wc == 1 && bj == 0) { col0 = 3648; nvalid = 8; } else { col0 = 0; nvalid = 0; } return; }
    const int s = T * 4 + wc;
    int base;
    if (s < 4) base = 0 + 64 * s; else if (s < 8) base = 256 + 64 * (s - 4); else if (s < 16) base = 768 + 64 * (s - 8); else if (s < 24) base = 1280 + 64 * (s - 16);
    else if (s < 28) base = 2304 + 64 * (s - 24); else if (s < 32) base = 2560 + 64 * (s - 28); else base = 3072 + 64 * (s - 32);
    col0 = base + d0;
}
DI void prologue_weights(const Params& p, unsigned char* lds) {
    const int tid = opaque_tid(), lane = tid & 63, wave = __builtin_amdgcn_readfirstlane(tid >> 6);
    LAS float* scr = (LAS float*)((LAS unsigned char*)lds) + wave * (64 * 33);
    const int gw = blockIdx.x * 8 + wave, NGW = gridDim.x * 8;
    constexpr int I1A = 88 * 16, I1B = 32 * 16, IO = 32 * 16, I3 = 176 * 16, ID = 32 * 44, IL = I1A + I1B + IO + I3 + ID;
    unsigned char* ws = p.ws;
    for (int it = gw; it < 2 * IL; it += NGW) {
        const int l = it / IL; int r = it - l * IL;
        if (r < I1A) { const int n0 = (r >> 4) * 32, k0 = (r & 15) * 64; int col0, nv; map_w1a(n0, col0, nv);
            wconv_item(p.w_in + (size_t)l * DM * INC, INC, col0, nv, p.attn_g + l * DM, (bf16_t*)(ws + WS_W1A) + (size_t)l * N1A * DM, DM, n0, k0, scr, lane); continue; }
        r -= I1A;
        if (r < I1B) { const int n0 = (r >> 4) * 32, k0 = (r & 15) * 64;
            const int col0 = n0 < 256 ? 512 + n0 : n0 < 768 ? 1792 + (n0 - 256) : 2816 + (n0 - 768);
            wconv_item(p.w_in + (size_t)l * DM * INC, INC, col0, 32, p.attn_g + l * DM, (bf16_t*)(ws + WS_W1B) + (size_t)l * DM * DM, DM, n0, k0, scr, lane); continue; }
        r -= I1B;
        if (r < IO) { const int n0 = (r >> 4) * 32, k0 = (r & 15) * 64;
            wconv_item(p.w_out + (size_t)l * DM * DM, DM, n0, 32, nullptr, (bf16_t*)(ws + WS_WO) + (size_t)l * DM * DM, DM, n0, k0, scr, lane); continue; }
        r -= IO;
        if (r < I3) { const int n0 = (r >> 4) * 32, k0 = (r & 15) * 64; const int T = n0 >> 8, c = n0 & 255, bj = c >> 7, cc = c & 127;
            const float* W = (bj ? p.w_up : p.w_gate) + (size_t)l * DM * DFF;
            wconv_item(W, DFF, 128 * T + cc, 32, p.ffn_g + l * DM, (bf16_t*)(ws + WS_W3) + (size_t)l * 2 * DFF * DM, DM, n0, k0, scr, lane); continue; }
        r -= I3;
        { const int n0 = (r / 44) * 32, k0 = (r % 44) * 64;
            wconv_item(p.w_down + (size_t)l * DFF * DM, DM, n0, 32, nullptr, (bf16_t*)(ws + WS_WD) + (size_t)l * DM * DFF, DFF, n0, k0, scr, lane); }
    }
    float* cs = (float*)(ws + WS_CS);
    for (int e = blockIdx.x * 512 + tid; e < SEQ * 32; e += gridDim.x * 512) {
        const int pos = e >> 5, i = e & 31;
        const float inv = 1.0f / exp2f((float)i * (13.287712379549449f / 32.f));
        const float ang = (float)pos * inv;
        double t = (double)ang * 0.15915494309189535; t -= __builtin_rint(t);
        const float f = (float)t;
        cs[pos * 64 + i] = __builtin_amdgcn_cosf(f); cs[pos * 64 + 32 + i] = __builtin_amdgcn_sinf(f);
    }
}
DI void norm_rows(const float* src, bf16_t* dst, float* rss) {
    const int tid = opaque_tid(), lane = tid & 63, wave = __builtin_amdgcn_readfirstlane(tid >> 6);
    const int gw = blockIdx.x * 8 + wave, NGW = gridDim.x * 8;
    for (int m = gw; m < MTOK; m += 2 * NGW) {
        const int m2 = (m + NGW < MTOK) ? m + NGW : m;
        const f32x4* xa = (const f32x4*)(src + (size_t)m * DM) + lane; const f32x4* xb2 = (const f32x4*)(src + (size_t)m2 * DM) + lane;
        f32x4 va[4], vb[4]; float sa = 0.f, sb = 0.f;
#pragma unroll
        for (int j = 0; j < 4; ++j) { va[j] = xa[64 * j]; vb[j] = xb2[64 * j]; }
#pragma unroll
        for (int j = 0; j < 4; ++j) { sa += (va[j][0] * va[j][0] + va[j][1] * va[j][1]) + (va[j][2] * va[j][2] + va[j][3] * va[j][3]); sb += (vb[j][0] * vb[j][0] + vb[j][1] * vb[j][1]) + (vb[j][2] * vb[j][2] + vb[j][3] * vb[j][3]); }
        sa = wave_sum(sa, lane); sb = wave_sum(sb, lane);
        if (lane == 0) { rss[m] = sa; rss[m2] = sb; }
        u32x2* oa = (u32x2*)(dst + (size_t)m * DM) + lane; u32x2* ob = (u32x2*)(dst + (size_t)m2 * DM) + lane;
#pragma unroll
        for (int j = 0; j < 4; ++j) { u32x2 w; w[0] = pk2(va[j][0], va[j][1]); w[1] = pk2(va[j][2], va[j][3]); oa[64 * j] = w; u32x2 w2; w2[0] = pk2(vb[j][0], vb[j][1]); w2[1] = pk2(vb[j][2], vb[j][3]); ob[64 * j] = w2; }
    }
}

constexpr int ROWB = 144, VROWB = 264, KS_BYTES = 128 * ROWB, VS_BYTES = 128 * VROWB;
constexpr int LDS_KS = 0, LDS_VS = 2 * KS_BYTES, LDS_TOP = LDS_VS + 3 * VS_BYTES;
constexpr int LDS_BST = LDS_TOP + 64, LDS_MISC = LDS_TOP + 128, LDS_QM = LDS_TOP + 256;
static_assert(LDS_TOP >= 131072 && LDS_QM + 1024 <= 147456, "LDS map");
constexpr float SM_C = 0.125f * 1.44269504089f;

template <int DV, int MODE>
DI void flash_pass(unsigned char* lds, const bf16_t* __restrict__ Qp, const bf16_t* __restrict__ Kp, const bf16_t* __restrict__ VTp, int q0,
                   f32x16 (&o)[DV / 32], float& m_run, float& l_run, unsigned qmask, unsigned umask, const u64* bmrow) {
    const int tid = opaque_tid(), lane = tid & 63, wave = __builtin_amdgcn_readfirstlane(tid >> 6), h = lane >> 5, ql = lane & 31;
    const int qw0 = q0 + 32 * wave, q = qw0 + ql;
    bf16x8 qf[4];
#pragma unroll
    for (int ks = 0; ks < 4; ++ks) qf[ks] = *(const GAS bf16x8*)(Qp + (size_t)q * 64 + 16 * ks + 8 * h);
#pragma unroll
    for (int dt = 0; dt < DV / 32; ++dt)
#pragma unroll
        for (int i = 0; i < 16; ++i) o[dt][i] = 0.f;
    m_run = NEG_INF; l_run = 0.f;
    const int ntile = (q0 + 256) >> 7;
    const int krow = tid >> 3, kch = tid & 7;
    const int vrow = tid >> 4, vch = tid & 15;
    int j = 0;
    if (MODE == 1) { while (j < ntile && !((umask >> (j >> 1)) & 1u)) j += 2; }
    u32x4 kreg[2]; u32x4 vreg[DV / 32]; u64 mreg0 = 0, mreg1 = 0;
    kreg[0] = (u32x4){0u, 0u, 0u, 0u}; kreg[1] = kreg[0];
#pragma unroll
    for (int i = 0; i < DV / 32; ++i) vreg[i] = kreg[0];
#define FL_LOADT(jj) do { const int k0_ = (jj) * 128; \
        kreg[0] = *(const GAS u32x4*)(Kp + (size_t)(k0_ + krow) * 64 + kch * 8); kreg[1] = *(const GAS u32x4*)(Kp + (size_t)(k0_ + 64 + krow) * 64 + kch * 8); \
        _Pragma("unroll") for (int i_ = 0; i_ < DV / 32; ++i_) vreg[i_] = *(const GAS u32x4*)(VTp + (size_t)(vrow + 32 * i_) * MTOK + k0_ + vch * 8); \
        if (MODE == 2) { mreg0 = *(const GAS u64*)(bmrow + 2 * (jj)); mreg1 = *(const GAS u64*)(bmrow + 2 * (jj) + 1); } } while (0)
#define FL_STORET(bb, vbb) do { *(u32x4*)(lds + LDS_KS + (bb) * KS_BYTES + krow * ROWB + kch * 16) = kreg[0]; *(u32x4*)(lds + LDS_KS + (bb) * KS_BYTES + (64 + krow) * ROWB + kch * 16) = kreg[1]; \
        _Pragma("unroll") for (int i_ = 0; i_ < DV / 32; ++i_) { unsigned char* vd_ = lds + LDS_VS + (vbb) * VS_BYTES + (vrow + 32 * i_) * VROWB + vch * 16; \
            *(u32x2*)vd_ = (u32x2){vreg[i_][0], vreg[i_][1]}; *(u32x2*)(vd_ + 8) = (u32x2){vreg[i_][2], vreg[i_][3]}; } } while (0)
#define FL_NEXT(jj, out) do { out = (jj) + 1; if (MODE == 1) { while (out < ntile && !((umask >> (out >> 1)) & 1u)) out = (out | 1) + 1; } } while (0)
    __syncthreads();
    u64 mc0 = 0, mc1 = 0; int jn = ntile, cur = 0, vb = 0;
    const bool grpB = (DV == 64) && (wave >= 4);
    u32x4 pprev[8]; int vprev = -1;
#pragma unroll
    for (int e = 0; e < 8; ++e) pprev[e] = (u32x4){0u, 0u, 0u, 0u};
#define FL_VLOAD(DST, G) do { _Pragma("unroll") for (int dt_ = 0; dt_ < DV / 32; ++dt_) { \
        const unsigned char* vp_ = VS_ + (32 * dt_ + ql) * VROWB + (16 * (G) + 4 * h) * 2; \
        (DST)[2 * dt_] = *(const s16x4*)vp_; (DST)[2 * dt_ + 1] = *(const s16x4*)(vp_ + 16); } } while (0)
#define FL_PV(PW, VBUF) do { const unsigned char* VS_ = lds + LDS_VS + (VBUF) * VS_BYTES; \
        s16x4 fa_[2 * (DV / 32)], fb_[2 * (DV / 32)]; \
        FL_VLOAD(fa_, 0); \
        _Pragma("unroll") for (int g_ = 0; g_ < 8; g_ += 2) { \
            FL_VLOAD(fb_, g_ + 1); \
            { const bf16x8 pb_ = __builtin_bit_cast(bf16x8, (PW)[g_]); \
              _Pragma("unroll") for (int dt_ = 0; dt_ < DV / 32; ++dt_) o[dt_] = MFMA32(__builtin_shufflevector(fa_[2 * dt_], fa_[2 * dt_ + 1], 0, 1, 2, 3, 4, 5, 6, 7), pb_, o[dt_]); } \
            if (g_ + 2 < 8) FL_VLOAD(fa_, g_ + 2); \
            { const bf16x8 pb_ = __builtin_bit_cast(bf16x8, (PW)[g_ + 1]); \
              _Pragma("unroll") for (int dt_ = 0; dt_ < DV / 32; ++dt_) o[dt_] = MFMA32(__builtin_shufflevector(fb_[2 * dt_], fb_[2 * dt_ + 1], 0, 1, 2, 3, 4, 5, 6, 7), pb_, o[dt_]); } \
        } } while (0)
    if (j < ntile) {
        FL_LOADT(j); FL_STORET(0, 0); mc0 = mreg0; mc1 = mreg1;
        FL_NEXT(j, jn);
        if (jn < ntile) FL_LOADT(jn);
    }
    __syncthreads();
    while (j < ntile) {
        if (grpB && vprev >= 0) { FL_PV(pprev, vprev); vprev = -1; }
        const bool selq = (MODE == 1) ? (((qmask >> (j >> 1)) & 1u) != 0u) : true;
        u64 selb = ~0ull;
        if (MODE == 1) selb = __ballot(selq);
        const int k0 = j * 128;
        if ((k0 <= qw0 + 31) && (selb != 0ull)) {
            const unsigned char* KS = lds + LDS_KS + cur * KS_BYTES;
            f32x16 st[4];
#pragma unroll
            for (int t = 0; t < 4; ++t)
#pragma unroll
                for (int i = 0; i < 16; ++i) st[t][i] = 0.f;
#pragma unroll
            for (int t = 0; t < 4; ++t)
#pragma unroll
                for (int ks = 0; ks < 4; ++ks) {
                    const bf16x8 ka = *(const bf16x8*)(KS + (32 * t + ql) * ROWB + (16 * ks + 8 * h) * 2);
                    st[t] = MFMA32(ka, qf[ks], st[t]);
                }
            if (MODE == 2) {
#pragma unroll
                for (int t = 0; t < 4; ++t) {
                    const u64 mcur = (t >> 1) ? mc1 : mc0;
                    const unsigned wsel = (unsigned)((t & 1) ? (mcur >> 32) : mcur) >> (4 * h);
#pragma unroll
                    for (int i = 0; i < 16; ++i) { const int kr = (i & 3) + 8 * (i >> 2); st[t][i] = (((wsel >> kr) & 1u) != 0u) ? st[t][i] : NEG_INF; }
                }
            } else {
                const bool need_mask = (k0 + 127 > qw0) || (MODE == 1 && selb != ~0ull);
                if (need_mask) {
                    const int dq = q - k0 - 4 * h;
#pragma unroll
                    for (int t = 0; t < 4; ++t)
#pragma unroll
                        for (int i = 0; i < 16; ++i) { const int kr = (i & 3) + 8 * (i >> 2) + 32 * t; st[t][i] = (selq && (kr <= dq)) ? st[t][i] : NEG_INF; }
                }
            }
            float mx = fmaxf(st[0][0], st[1][0]);
#pragma unroll
            for (int i = 0; i < 16; ++i) mx = fmaxf(fmaxf(mx, st[0][i]), fmaxf(st[1][i], fmaxf(st[2][i], st[3][i])));
            mx = fmaxf(mx, shx(mx, 32, lane)) * SM_C;
            const float m_new = fmaxf(m_run, mx), m_use = (m_new == NEG_INF) ? 0.f : m_new;
            const float alpha = __builtin_amdgcn_exp2f(m_run - m_use);
            const f32x2_t c2 = {SM_C, SM_C}, nm2 = {-m_use, -m_use};
            f32x2_t ps2 = {0.f, 0.f};
#pragma unroll
            for (int t = 0; t < 4; ++t)
#pragma unroll
                for (int i = 0; i < 16; i += 2) {
                    f32x2_t a2 = {st[t][i], st[t][i + 1]};
                    a2 = a2 * c2 + nm2;
                    f32x2_t e2; e2[0] = __builtin_amdgcn_exp2f(a2[0]); e2[1] = __builtin_amdgcn_exp2f(a2[1]);
                    st[t][i] = e2[0]; st[t][i + 1] = e2[1]; ps2 = ps2 + e2;
                }
            l_run = l_run * alpha + (ps2[0] + ps2[1]);
            if (__ballot(m_new > m_run) != 0ull) {
#pragma unroll
                for (int dt = 0; dt < DV / 32; ++dt) o[dt] = o[dt] * alpha;
            }
            m_run = m_new;
#pragma unroll
            for (int t = 0; t < 4; ++t)
#pragma unroll
                for (int s2 = 0; s2 < 2; ++s2) {
                    pprev[2 * t + s2][0] = pk2(st[t][8 * s2], st[t][8 * s2 + 1]); pprev[2 * t + s2][1] = pk2(st[t][8 * s2 + 2], st[t][8 * s2 + 3]);
                    pprev[2 * t + s2][2] = pk2(st[t][8 * s2 + 4], st[t][8 * s2 + 5]); pprev[2 * t + s2][3] = pk2(st[t][8 * s2 + 6], st[t][8 * s2 + 7]);
                }
            if (!grpB) { FL_PV(pprev, vb); } else vprev = vb;
        }
        int jnn = ntile; u64 mn0 = 0, mn1 = 0;
        const int vbn = (vb == 2) ? 0 : vb + 1;
        if (jn < ntile) { FL_STORET(cur ^ 1, vbn); mn0 = mreg0; mn1 = mreg1; FL_NEXT(jn, jnn); if (jnn < ntile) FL_LOADT(jnn); }
        asm volatile("s_waitcnt lgkmcnt(0)\n\ts_barrier" ::: "memory");
        j = jn; jn = jnn; cur ^= 1; vb = vbn; mc0 = mn0; mc1 = mn1;
    }
    if (grpB && vprev >= 0) { FL_PV(pprev, vprev); }
#undef FL_PV
#undef FL_VLOAD
#undef FL_LOADT
#undef FL_STORET
#undef FL_NEXT
}

DI void write_o64(const f32x16 (&o)[2], float l_run, bf16_t* mixrow  , int wave, int lane) {
    const int h = lane >> 5, ql = lane & 31;
    const float inv = 1.f / (l_run + shx(l_run, 32, lane));
    bf16_t* rp = mixrow + (size_t)(32 * wave + ql) * DM;
#pragma unroll
    for (int dt = 0; dt < 2; ++dt)
#pragma unroll
        for (int g = 0; g < 4; ++g) {
            u32x2 w; w[0] = pk2(o[dt][4 * g] * inv, o[dt][4 * g + 1] * inv); w[1] = pk2(o[dt][4 * g + 2] * inv, o[dt][4 * g + 3] * inv);
            *(GAS u32x2*)(rp + 32 * dt + 8 * g + 4 * h) = w;
        }
}

DI void moba_unit(const Params& p, unsigned char* lds, int l, int b, int hh, int cur) {
    const int tid = opaque_tid(), lane = tid & 63, wave = __builtin_amdgcn_readfirstlane(tid >> 6);
    const bf16_t* QK = gp((const bf16_t*)(p.ws + WS_QK));
    const bf16_t* Qp = QK + ((size_t)(0 + hh) * MTOK + (size_t)b * SEQ) * 64;
    const bf16_t* Kp = QK + ((size_t)(4 + hh) * MTOK + (size_t)b * SEQ) * 64;
    const bf16_t* VTp = gp((const bf16_t*)(p.ws + WS_VT)) + (size_t)(64 * hh) * MTOK + (size_t)b * SEQ;
    const float* kmean = gp((const float*)(p.ws + WS_KMEAN)) + (size_t)l * 32768;
    volatile unsigned* QM = (volatile unsigned*)(lds + LDS_QM); unsigned* MISC = (unsigned*)(lds + LDS_MISC);
    const int q0 = cur * 256;
    float* kml = (float*)(lds + LDS_KS);
    for (int e = tid; e < cur * 64; e += 512) kml[e] = kmean[((size_t)(b * 16 + (e >> 6)) * 4 + hh) * 64 + (e & 63)];
    __syncthreads();
    if (tid < 256) {
        const u32x4* qr = (const u32x4*)(Qp + (size_t)(q0 + tid) * 64);
        float qv[64];
#pragma unroll
        for (int c = 0; c < 8; ++c) { const u32x4 w = qr[c];
#pragma unroll
            for (int e = 0; e < 4; ++e) { qv[8 * c + 2 * e] = bf_lo(w[e]); qv[8 * c + 2 * e + 1] = bf_hi(w[e]); } }
        float b0 = NEG_INF, b1 = NEG_INF, b2 = NEG_INF; int i0 = -1, i1 = -1, i2 = -1;
        for (int n = 0; n < cur; ++n) {
            const f32x4* km = (const f32x4*)(kml + n * 64);
            float g = 0.f;
#pragma unroll
            for (int d4 = 0; d4 < 16; ++d4) { const f32x4 k4 = km[d4]; g = fmaf(qv[4 * d4], k4[0], g); g = fmaf(qv[4 * d4 + 1], k4[1], g); g = fmaf(qv[4 * d4 + 2], k4[2], g); g = fmaf(qv[4 * d4 + 3], k4[3], g); }
            if (g > b0) { b2 = b1; i2 = i1; b1 = b0; i1 = i0; b0 = g; i0 = n; }
            else if (g > b1) { b2 = b1; i2 = i1; b1 = g; i1 = n; }
            else if (g > b2) { b2 = g; i2 = n; }
        }
        unsigned mask = 1u << cur;
        if (i0 >= 0) mask |= 1u << i0; if (i1 >= 0) mask |= 1u << i1; if (i2 >= 0) mask |= 1u << i2;
        QM[tid] = mask; atomicOr(&MISC[1], mask);
    }
    __syncthreads();
    const unsigned umask = MISC[1], qmask = QM[32 * wave + (lane & 31)];
    f32x16 o[2]; float m_run, l_run;
    flash_pass<64, 1>(lds, Qp, Kp, VTp, q0, o, m_run, l_run, qmask, umask, nullptr);
    write_o64(o, l_run, gp((bf16_t*)p.out + (size_t)MTOK * DM) + ((size_t)b * SEQ + q0) * DM + 64 * hh, wave, lane);
}

DI void dsa_unit(const Params& p, unsigned char* lds, int b, int hh, int cur) {
    const int tid = opaque_tid(), lane = tid & 63, wave = __builtin_amdgcn_readfirstlane(tid >> 6);
    const bf16_t* QK = gp((const bf16_t*)(p.ws + WS_QK));
    const bf16_t* Qp = QK + ((size_t)(24 + hh) * MTOK + (size_t)b * SEQ) * 64;
    const bf16_t* Kp = QK + ((size_t)(28 + hh) * MTOK + (size_t)b * SEQ) * 64;
    const bf16_t* VTp = gp((const bf16_t*)(p.ws + WS_VT)) + (size_t)(768 + 64 * hh) * MTOK + (size_t)b * SEQ;
    const int q0 = cur * 256;
    const u64* bmrow = gp((const u64*)(p.ws + WS_BM)) + ((size_t)b * SEQ + q0 + 32 * wave + (lane & 31)) * 64;
    f32x16 o[2]; float m_run, l_run;
    flash_pass<64, 2>(lds, Qp, Kp, VTp, q0, o, m_run, l_run, 0u, 0u, bmrow);
    write_o64(o, l_run, gp((bf16_t*)p.out + (size_t)MTOK * DM) + ((size_t)b * SEQ + q0) * DM + 768 + 64 * hh, wave, lane);
}

DI void diff_unit(const Params& p, unsigned char* lds, int l, int b, int hh, int cur) {
    const int tid = opaque_tid(), lane = tid & 63, wave = __builtin_amdgcn_readfirstlane(tid >> 6), h = lane >> 5, ql = lane & 31;
    const bf16_t* QK = gp((const bf16_t*)(p.ws + WS_QK));
    const bf16_t* VTp = gp((const bf16_t*)(p.ws + WS_VT)) + (size_t)(256 + 128 * hh) * MTOK + (size_t)b * SEQ;
    const int q0 = cur * 256;
    f32x16 o1[4]; float m1, l1;
    float* sto = gp((float*)(p.ws + WS_SCR)) + (size_t)blockIdx.x * (32 * SEQ) + (size_t)(32 * wave + ql) * 128;
    flash_pass<128, 0>(lds, QK + ((size_t)(8 + 2 * hh) * MTOK + (size_t)b * SEQ) * 64, QK + ((size_t)(16 + 2 * hh) * MTOK + (size_t)b * SEQ) * 64, VTp, q0, o1, m1, l1, 0u, 0u, nullptr);
    {
        const float r1 = 1.f / (l1 + shx(l1, 32, lane));
#pragma unroll
        for (int dt = 0; dt < 4; ++dt)
#pragma unroll
            for (int g = 0; g < 4; ++g) { f32x4 v = {o1[dt][4 * g] * r1, o1[dt][4 * g + 1] * r1, o1[dt][4 * g + 2] * r1, o1[dt][4 * g + 3] * r1}; *(f32x4*)(sto + 32 * dt + 8 * g + 4 * h) = v; }
    }
    flash_pass<128, 0>(lds, QK + ((size_t)(9 + 2 * hh) * MTOK + (size_t)b * SEQ) * 64, QK + ((size_t)(17 + 2 * hh) * MTOK + (size_t)b * SEQ) * 64, VTp, q0, o1, m1, l1, 0u, 0u, nullptr);
    const float* lp = p.dlam + l * 256;
    float d1 = 0.f, d2 = 0.f;
    for (int d = 0; d < 64; ++d) { d1 = fmaf(lp[d], lp[64 + d], d1); d2 = fmaf(lp[128 + d], lp[192 + d], d2); }
    const float lam_init = (l == 0) ? 0.2f : (0.8f - 0.6f * 0.7408182206817179f);
    const float lam = expf(d1) - expf(d2) + lam_init;
    const float r2 = lam / (l1 + shx(l1, 32, lane));
    float ss = 0.f;
#pragma unroll
    for (int dt = 0; dt < 4; ++dt)
#pragma unroll
        for (int g = 0; g < 4; ++g) {
            const f32x4 a = *(const f32x4*)(sto + 32 * dt + 8 * g + 4 * h);
#pragma unroll
            for (int e = 0; e < 4; ++e) { const float v = a[e] - o1[dt][4 * g + e] * r2; o1[dt][4 * g + e] = v; ss = fmaf(v, v, ss); }
        }
    ss += shx(ss, 32, lane);
    const float rn = rsqrtf(ss * (1.f / 128.f) + EPS) * (1.f - lam_init);
    const float* sg = p.subln + l * 128;
    bf16_t* rp = gp((bf16_t*)p.out + (size_t)MTOK * DM) + ((size_t)b * SEQ + q0 + 32 * wave + ql) * DM + 256 + 128 * hh;
#pragma unroll
    for (int dt = 0; dt < 4; ++dt)
#pragma unroll
        for (int g = 0; g < 4; ++g) {
            const int d0 = 32 * dt + 8 * g + 4 * h;
            const f32x4 gv = *(const f32x4*)(sg + d0);
            u32x2 w; w[0] = pk2(o1[dt][4 * g] * rn * gv[0], o1[dt][4 * g + 1] * rn * gv[1]); w[1] = pk2(o1[dt][4 * g + 2] * rn * gv[2], o1[dt][4 * g + 3] * rn * gv[3]);
            *(u32x2*)(rp + d0) = w;
        }
}

DI unsigned ord_key(float v) { v += 0.f; const unsigned b = __builtin_bit_cast(unsigned, v); return b ^ ((b & 0x80000000u) ? 0xffffffffu : 0x80000000u); }
constexpr int LDS_SEL = 61440, SEL_STRIDE = 6144;
DI float key_f(unsigned u) { const unsigned b = (u & 0x80000000u) ? (u ^ 0x80000000u) : ~u; return __builtin_bit_cast(float, b); }
DI void select_unit(const Params& p, unsigned char* lds, int b, int q0) {
    const int tid = opaque_tid(), lane = tid & 63, wave = __builtin_amdgcn_readfirstlane(tid >> 6);
    float* scr = gp((float*)(p.ws + WS_SCR)) + (size_t)blockIdx.x * (32 * SEQ);
    u64* bm = gp((u64*)(p.ws + WS_BM));
    if (q0 >= 256) {
        const bf16_t* QK = gp((const bf16_t*)(p.ws + WS_QK));
        const bf16_t* IK = QK + ((size_t)40 * MTOK + (size_t)b * SEQ) * 64;
        const int qi = lane & 15, kq = lane >> 4, qrow = 16 * (wave >> 2) + qi, kw = wave & 3;
        const float* iwp = gp((const float*)(p.ws + WS_IW)) + ((size_t)b * SEQ + q0 + qrow) * 8;
        bf16x8 qf[8][2]; float w[8];
        const f32x4 wa = *(const f32x4*)iwp, wb = *(const f32x4*)(iwp + 4);
#pragma unroll
        for (int e = 0; e < 4; ++e) { w[e] = wa[e]; w[4 + e] = wb[e]; }
#pragma unroll
        for (int hh = 0; hh < 8; ++hh)
#pragma unroll
            for (int ks = 0; ks < 2; ++ks) qf[hh][ks] = *(const bf16x8*)(QK + ((size_t)(32 + hh) * MTOK + (size_t)b * SEQ + q0 + qrow) * 64 + 32 * ks + 8 * kq);
        const int n32 = (q0 + 32) >> 5;
        const bf16_t* kbase = IK + (size_t)qi * 64 + 8 * kq;
        for (int srep = 0; srep < SEL_REP_SCORE; ++srep) {
        bf16x8 kf[2][2];
        if (kw < n32) {
#pragma unroll
            for (int sub = 0; sub < 2; ++sub)
#pragma unroll
                for (int ks = 0; ks < 2; ++ks) kf[sub][ks] = *(const GAS bf16x8*)(kbase + (size_t)(32 * kw + 16 * sub) * 64 + 32 * ks);
        }
#pragma unroll 1
        for (int t = kw; t < n32; t += 4) {
            const int k0 = 32 * t;
            bf16x8 kn[2][2];
            const int tn = (t + 4 < n32) ? t + 4 : t;
#pragma unroll
            for (int sub = 0; sub < 2; ++sub)
#pragma unroll
                for (int ks = 0; ks < 2; ++ks) kn[sub][ks] = *(const GAS bf16x8*)(kbase + (size_t)(32 * tn + 16 * sub) * 64 + 32 * ks);
            f32x4 sc[2];
#pragma unroll
            for (int sub = 0; sub < 2; ++sub) sc[sub] = (f32x4){0.f, 0.f, 0.f, 0.f};
#pragma unroll
            for (int hh = 0; hh < 8; ++hh)
#pragma unroll
                for (int sub = 0; sub < 2; ++sub) {
                    f32x4 a = {0.f, 0.f, 0.f, 0.f};
                    a = __builtin_amdgcn_mfma_f32_16x16x32_bf16(kf[sub][0], qf[hh][0], a, 0, 0, 0);
                    a = __builtin_amdgcn_mfma_f32_16x16x32_bf16(kf[sub][1], qf[hh][1], a, 0, 0, 0);
#pragma unroll
                    for (int i = 0; i < 4; ++i) sc[sub][i] = fmaf(w[hh], fmaxf(a[i], 0.f), sc[sub][i]);
                    if (sub == 1 && (hh & 3) == 3) __builtin_amdgcn_sched_barrier(0);
                }
#pragma unroll
            for (int sub = 0; sub < 2; ++sub) *(GAS f32x4*)(scr + (size_t)qrow * SEQ + k0 + 16 * sub + 4 * kq) = sc[sub];
#pragma unroll
            for (int sub = 0; sub < 2; ++sub)
#pragma unroll
                for (int ks = 0; ks < 2; ++ks) kf[sub][ks] = kn[sub][ks];
        }
        }
        __syncthreads();
    }
    LAS unsigned* hist = (LAS unsigned*)((LAS unsigned char*)lds + LDS_SEL + wave * SEL_STRIDE + 16);
    LAS float* listv = (LAS float*)(hist + 1024);
    LAS int* listi = (LAS int*)(hist + 1088);
    LAS unsigned* misc = hist + 1152;
#define SEL_CB() asm volatile("" ::: "memory")
#define SEL_WAIT() asm volatile("s_waitcnt lgkmcnt(0)" ::: "memory")
#pragma unroll 1
    for (int rr0 = 0; rr0 < 4 * SEL_REP_ROWS; ++rr0) {
        const int rr = rr0 & 3;
        const int r = wave * 4 + rr, qpos = q0 + r;
        int ln = lane; asm volatile("" : "+v"(ln));
        u64* bmr = bm + ((size_t)b * SEQ + qpos) * 64;
        if (qpos < 256) {
            const int rem = qpos - ln * 64;
            bmr[ln] = (rem >= 63) ? ~0ull : (rem < 0) ? 0ull : ((2ull << rem) - 1ull);
            continue;
        }
        const int ng = (qpos >> 9) + 1;
        float v[64];
        const float* sr = scr + (size_t)r * SEQ;
#pragma unroll
        for (int g8 = 0; g8 < 8; ++g8) {
#pragma unroll
            for (int jj = 0; jj < 8; ++jj) v[8 * g8 + jj] = NEG_INF;
            if (g8 < ng) {
#pragma unroll
                for (int jj = 0; jj < 8; ++jj) { const int j = 8 * g8 + jj; const float t = *(const GAS float*)(sr + 64 * j + ln); v[j] = (ln <= qpos - 64 * j) ? (t + 0.f) : NEG_INF; }
            }
        }
        float lmax = NEG_INF, lmin = -NEG_INF;
#pragma unroll
        for (int g8 = 0; g8 < 8; ++g8) {
            if (g8 < ng) {
#pragma unroll
                for (int jj = 0; jj < 8; ++jj) { const int j = 8 * g8 + jj; lmax = fmaxf(lmax, v[j]); lmin = fminf(lmin, (v[j] == NEG_INF) ? -NEG_INF : v[j]); }
            }
        }
        SEL_WAIT();
        if (ln == 0) { misc[0] = 0u; misc[1] = 0xffffffffu; misc[2] = 0u; }
        {
            LAS u32x4* hz = (LAS u32x4*)(hist + 16 * ln);
            const u32x4 z = {0u, 0u, 0u, 0u};
            hz[0] = z; hz[1] = z; hz[2] = z; hz[3] = z;
        }
        SEL_CB();
        atomicMax((unsigned*)&misc[0], ord_key(lmax)); atomicMin((unsigned*)&misc[1], ord_key(lmin));
        SEL_WAIT();
        const float hi = key_f(misc[0]), lo = key_f(misc[1]);
        const float inv = 1024.f / (hi - lo), c0 = -lo * inv;
        bool fast = (hi > lo) && (inv < 1e37f);
        float Tv = 0.f; int Ti = 0;
        if (fast) {
            unsigned pb[32];
#pragma unroll
            for (int e = 0; e < 32; ++e) pb[e] = 0u;
#pragma unroll
            for (int g8 = 0; g8 < 8; ++g8) {
                if (g8 < ng) {
#pragma unroll
                    for (int jj = 0; jj < 8; ++jj) { const int j = 8 * g8 + jj;
                        int bin = (int)fmaf(v[j], inv, c0); bin = bin < -1 ? -1 : (bin > 1023 ? 1023 : bin);
                        atomicAdd((unsigned*)(hist + bin), 1u);
                        for (int xa = 0; xa < PROBE_XATOM; ++xa) atomicAdd((unsigned*)(hist + bin), 0u);
                        pb[j >> 1] |= (unsigned)(bin + 1) << (16 * (j & 1)); }
                }
            }
            SEL_WAIT();
            unsigned c[16]; unsigned tot = 0;
            {
                LAS u32x4* hz = (LAS u32x4*)(hist + 16 * ln);
#pragma unroll
                for (int e = 0; e < 4; ++e) { const u32x4 t4 = hz[e]; c[4 * e] = t4[0]; c[4 * e + 1] = t4[1]; c[4 * e + 2] = t4[2]; c[4 * e + 3] = t4[3]; tot += t4[0] + t4[1] + t4[2] + t4[3]; }
            }
            unsigned suf = tot;
#pragma unroll
            for (int d = 1; d < 64; d <<= 1) { const unsigned o = (unsigned)__builtin_amdgcn_ds_bpermute(((ln + d) & 63) << 2, (int)suf); suf += (ln + d < 64) ? o : 0u; }
            const u64 ge = __ballot(suf >= 256u);
            const int Ls = 63 - __builtin_clzll(ge);
            unsigned cum = suf - tot; int bsel = 0; unsigned above = 0, cstar = 0; bool found = false;
#pragma unroll
            for (int t = 15; t >= 0; --t) { if (!found && cum + c[t] >= 256u) { found = true; bsel = 16 * ln + t; above = cum; cstar = c[t]; } cum += c[t]; }
            const int bstar = __builtin_amdgcn_readlane(bsel, Ls); const int need = 256 - __builtin_amdgcn_readlane((int)above, Ls); const int ncand = __builtin_amdgcn_readlane((int)cstar, Ls);
            if (ncand > 64) fast = false;
            else {
                SEL_CB();
                const unsigned blo = (unsigned)(bstar + 1), bhi = blo << 16;
#pragma unroll
                for (int g8 = 0; g8 < 8; ++g8) {
                    if (g8 < ng) {
#pragma unroll
                        for (int jj = 0; jj < 8; ++jj) { const int j = 8 * g8 + jj;
                            const bool is = (j & 1) ? ((pb[j >> 1] & 0xffff0000u) == bhi) : ((pb[j >> 1] & 0xffffu) == blo);
                            if (is) { const unsigned pos = atomicAdd((unsigned*)&misc[2], 1u); listv[pos & 63] = v[j]; listi[pos & 63] = 64 * j + ln; } }
                    }
                }
                SEL_WAIT();
                const float mv = listv[ln]; const int mi = listi[ln];
                int rank = 0;
                for (int i = 0; i < ncand; ++i) { const float ov = listv[i]; const int oi = listi[i]; rank += ((ov > mv) || (ov == mv && oi < mi)) ? 1 : 0; }
                const u64 hit = __ballot(ln < ncand && rank == need - 1);
                const int Lt = __builtin_ctzll(hit);
                Tv = __builtin_bit_cast(float, __builtin_amdgcn_readlane(__builtin_bit_cast(int, mv), Lt)); Ti = __builtin_amdgcn_readlane(mi, Lt);
            }
        }
        if (!fast) {
            unsigned T = 0u;
#pragma unroll 1
            for (int bit = 31; bit >= 0; --bit) {
                const unsigned cand = T | (1u << bit);
                int cc = 0;
#pragma unroll
                for (int j = 0; j < 64; ++j) cc += (v[j] != NEG_INF && ord_key(v[j]) >= cand) ? 1 : 0;
                int totc = 0;
#pragma unroll
                for (int bb = 0; bb < 7; ++bb) totc += __builtin_popcountll(__ballot((cc >> bb) & 1)) << bb;
                if (totc >= 256) T = cand;
            }
            Tv = key_f(T);
            int cc = 0;
#pragma unroll
            for (int j = 0; j < 64; ++j) cc += (v[j] > Tv) ? 1 : 0;
            int cgt = 0;
#pragma unroll
            for (int bb = 0; bb < 7; ++bb) cgt += __builtin_popcountll(__ballot((cc >> bb) & 1)) << bb;
            const int need = 256 - cgt;
            int taken = 0; Ti = -1;
#pragma unroll
            for (int j = 0; j < 64; ++j) {
                const u64 eq = __ballot(v[j] == Tv);
                const int ce = __builtin_popcountll(eq);
                if (Ti < 0 && taken + ce >= need) {
                    int k = need - taken; u64 e = eq; int lanepos = 0;
                    while (k > 0) { lanepos = __builtin_ctzll(e); e &= e - 1; --k; }
                    Ti = 64 * j + lanepos;
                }
                taken += ce;
            }
        }
        unsigned wlo = 0u, whi = 0u;
#pragma unroll
        for (int g8 = 0; g8 < 8; ++g8) {
            if (g8 < ng) {
#pragma unroll
                for (int jj = 0; jj < 8; ++jj) { const int j = 8 * g8 + jj;
                    const u64 word = __ballot((v[j] > Tv) || (v[j] == Tv && ln <= Ti - 64 * j));
                    if (ln == j) { wlo = (unsigned)word; whi = (unsigned)(word >> 32); } }
            }
        }
        *(GAS u64*)(bmr + ln) = (u64)wlo | ((u64)whi << 32);
    }
#undef SEL_CB
#undef SEL_WAIT
}

DI void kmean_unit(const Params& p, unsigned char* lds, int l, int b, int hh, int blk) {
    const int tid = opaque_tid(), lane = tid & 63, wave = __builtin_amdgcn_readfirstlane(tid >> 6), ch = tid & 7, rg = tid >> 3;
    const bf16_t* Kp = gp((const bf16_t*)(p.ws + WS_QK)) + ((size_t)(4 + hh) * MTOK + (size_t)b * SEQ + blk * 256) * 64;
    float a[8];
#pragma unroll
    for (int e = 0; e < 8; ++e) a[e] = 0.f;
#pragma unroll
    for (int i = 0; i < 4; ++i) { const u32x4 w = *(const u32x4*)(Kp + (size_t)(rg + 64 * i) * 64 + ch * 8);
#pragma unroll
        for (int e = 0; e < 4; ++e) { a[2 * e] += bf_lo(w[e]); a[2 * e + 1] += bf_hi(w[e]); } }
#pragma unroll
    for (int e = 0; e < 8; ++e) { float v = a[e]; v += shx(v, 8, lane); v += shx(v, 16, lane); v += shx(v, 32, lane); a[e] = v; }
    float* red = (float*)(lds + LDS_KS);
    if (lane < 8) {
#pragma unroll
        for (int e = 0; e < 8; ++e) red[wave * 64 + lane * 8 + e] = a[e];
    }
    __syncthreads();
    if (tid < 64) { float sacc = 0.f;
#pragma unroll
        for (int w = 0; w < 8; ++w) sacc += red[w * 64 + tid];
        (gp((float*)(p.ws + WS_KMEAN)))[(size_t)l * 32768 + ((size_t)(b * 16 + blk) * 4 + hh) * 64 + tid] = sacc * (1.f / 256.f); }
}

#define XB_TMO      128
#define XB_XCNT(j)  (256  + 64 * (j))
#define XB_XSUB(j)  (1280 + 64 * (j))
#define XB_XGEN(j)  (2304 + 64 * (j))
#define XB_TOP      3328
#define XB_TOPGEN   3392
#define XCD_BAR_WORDS 3456
#define XB_SPIN_CAP (1u << 18)

__device__ __forceinline__ unsigned xb_ld(unsigned* p)              { return __hip_atomic_load(p, __ATOMIC_RELAXED, __HIP_MEMORY_SCOPE_AGENT); }
__device__ __forceinline__ unsigned xb_add(unsigned* p, unsigned v) { return __hip_atomic_fetch_add(p, v, __ATOMIC_RELAXED, __HIP_MEMORY_SCOPE_AGENT); }
__device__ __forceinline__ unsigned xb_xcc_id() { return (unsigned)__builtin_amdgcn_s_getreg((3 << 11) | 20) & 0xFu; }
#define XB_SPIN(cond, bar) do { unsigned _sp = 0; while (cond) { __builtin_amdgcn_s_sleep(1); \
    if ((++_sp & 255u) == 0u) { if (xb_ld(&(bar)[XB_TMO])) break; if (_sp > XB_SPIN_CAP) { atomicAdd(&(bar)[XB_TMO], 1u); break; } } } } while (0)

struct XcdBarrier {
    unsigned* bar; unsigned x;
    volatile LAS unsigned* st;
};

__device__ __forceinline__ XcdBarrier xcd_barrier_post(unsigned* bar, volatile LAS unsigned* st) {
    XcdBarrier b; b.bar = bar; b.x = xb_xcc_id(); b.st = st;
    if (threadIdx.x == 0) (void)xb_add(&bar[XB_XCNT(b.x)], 1u);
    return b;
}
__device__ __forceinline__ void xcd_barrier_complete(unsigned* bar, unsigned x, unsigned& nloc, unsigned& nx) {
    const unsigned G = gridDim.x * gridDim.y * gridDim.z;
    unsigned sum, cnt, mine, sp = 0u;
    for (;;) {
        sum = 0u; cnt = 0u; mine = 0u;
#pragma unroll
        for (unsigned j = 0; j < 16; ++j) { const unsigned c = xb_ld(&bar[XB_XCNT(j)]); sum += c; cnt += (c > 0u) ? 1u : 0u; mine = (j == x) ? c : mine; }
        if (sum == G) break;
        __builtin_amdgcn_s_sleep(1);
        if ((++sp & 255u) == 0u) { if (xb_ld(&bar[XB_TMO])) break; if (sp > XB_SPIN_CAP) { atomicAdd(&bar[XB_TMO], 1u); break; } }
    }
    nloc = mine > 0u ? mine : 1u; nx = cnt > 0u ? cnt : 1u;
}

__device__ __forceinline__ void xcd_barrier(const XcdBarrier& b) {
    asm volatile("s_waitcnt vmcnt(0)" ::: "memory");
    __syncthreads();
    if (threadIdx.x == 0) {
        unsigned* bar = b.bar;
        __builtin_amdgcn_s_waitcnt(0);
        unsigned nloc = b.st[0], nx = b.st[1];
        if (nloc == 0u) { xcd_barrier_complete(bar, b.x, nloc, nx); b.st[0] = nloc; b.st[1] = nx; }
        const unsigned old = xb_add(&bar[XB_XSUB(b.x)], 1u);
        const unsigned gen = old / nloc;
        if (old + 1u == (gen + 1u) * nloc) {
            __builtin_amdgcn_fence(__ATOMIC_RELEASE, "agent");
            asm volatile("s_waitcnt vmcnt(0)" ::: "memory");
            const unsigned og = xb_add(&bar[XB_TOP], 1u);
            const unsigned tg = og / nx;
            if (og + 1u == (tg + 1u) * nx) xb_add(&bar[XB_TOPGEN], 1u);
            else XB_SPIN(xb_ld(&bar[XB_TOPGEN]) == tg, bar);
            __builtin_amdgcn_fence(__ATOMIC_ACQUIRE, "agent");
            xb_add(&bar[XB_XGEN(b.x)], 1u);
            asm volatile("s_waitcnt vmcnt(0)" ::: "memory");
        } else {
            XB_SPIN(xb_ld(&bar[XB_XGEN(b.x)]) == gen, bar);
            __builtin_amdgcn_fence(__ATOMIC_ACQUIRE, "agent");
            asm volatile("s_waitcnt vmcnt(0)" ::: "memory");
        }
    }
    __syncthreads();
}

DI int next_item(unsigned char* lds, unsigned* ctr) {
    unsigned* MISC = (unsigned*)(lds + LDS_MISC);
    __syncthreads();
    if (opaque_tid() == 0) { MISC[0] = atomicAdd(ctr, 1u); MISC[1] = 0u; }
    __syncthreads();
    return (int)MISC[0];
}

__global__ void __launch_bounds__(512, 2) mega_fwd(Params p) {
    extern __shared__ __attribute__((aligned(16))) unsigned char lds[];
    cg::grid_group grid = cg::this_grid();
    const int tid = opaque_tid(), lane = tid & 63, wave = __builtin_amdgcn_readfirstlane(tid >> 6);
    PG8_LAS unsigned char* lds3 = (PG8_LAS unsigned char*)lds;
    const Params& p0 = p;
    if (p0.ph_lo < 0) grid.sync();
    volatile LAS unsigned* bst = (volatile LAS unsigned*)(lds3 + LDS_BST);
    if (threadIdx.x == 0) { bst[0] = 0u; bst[1] = 0u; }
    __syncthreads();
    const XcdBarrier gbar = xcd_barrier_post((unsigned*)(p0.ws + WS_CTL) + CW_BAR, bst);
#define GSYNC() xcd_barrier(gbar)
    for (int xs = 0; xs < EXTRA_SYNCS; ++xs) GSYNC();
    for (int ph = p0.ph_lo; ph < p0.ph_hi; ++ph) {
        if ((ph & 7) == 5 || ph == 8) continue;
        if (ph > p0.ph_lo) GSYNC();
        Params p = p0;
        { unsigned char* w_ = p0.ws; asm volatile("" : "+s"(w_)); p.ws = (unsigned char*)(__attribute__((address_space(1))) unsigned char*)w_; }
        unsigned char* ws = p.ws;
        bf16_t* XB = (bf16_t*)(ws + WS_XB);
        unsigned* ctr = (unsigned*)(ws + WS_CTL);
        const int l = ph >> 3, k = ph & 7;
        const float* xin = (l == 0) ? p.x : p.out;
        const int nrep = ((REP_MASK >> k) & 1) ? 2 : 1;
        for (int rep = 0; rep < nrep; ++rep) {
        if (rep > 0) GSYNC();
        if (k == 0 && (PH_MASK & 1)) {
            if (l == 0) prologue_weights(p, lds);
            norm_rows(xin, XB, (float*)(ws + WS_RSS));
        } else if (k == 1 && (PH_MASK & 2)) {
#if !defined(SKIP_G1A)
            const bf16_t* XA = (l == 0) ? XB : (const bf16_t*)p.out;
            { pg8::Gemm g{XA, (const bf16_t*)(ws + WS_W1A) + (size_t)l * N1A * DM, MTOK, N1A, DM}; pg8::StaticOrder S; S.init(MTOK, N1A, gridDim.x, blockIdx.x);
              EpiQK E{(bf16_t*)(ws + WS_QK), (float*)(ws + WS_IW), (const float*)(ws + WS_CS), p.qg + l * 192, p.kg + l * 192, (const float*)(ws + WS_RSS) + (size_t)(2 * l) * MTOK};
              pg8::gemm_phase<EpiQK, pg8::StaticOrder, true, true>(lds3, g, S, E); }
#endif
#if !defined(SKIP_G1B)
            { pg8::Gemm g{(const bf16_t*)(ws + WS_W1B) + (size_t)l * DM * DM, XA, DM, MTOK, DM}; pg8::StaticOrder S; S.init(DM, MTOK, gridDim.x, blockIdx.x);
              EpiVT E{(bf16_t*)(ws + WS_VT), MTOK, (const float*)(ws + WS_RSS) + (size_t)(2 * l) * MTOK};
              pg8::gemm_phase<EpiVT, pg8::StaticOrder, true, true>(lds3, g, S, E); }
#endif
        } else if (k == 2 && (PH_MASK & 4)) {
            for (;;) {
                const int it = next_item(lds, ctr + 16 * (2 * l) + 64 * rep);
                if (it >= 512 + 1024 + 512) break;
                if (it < 512) {
#if !defined(SKIP_DIFF)
                    if (!(REP_SKIP_DIFF && rep > 0)) diff_unit(p, lds, l, (it & 31) >> 2, it & 3, 15 - (it >> 5));
#endif
                } else if (it < 1536) {
#if !defined(SKIP_SEL)
                    const int s = it - 512; select_unit(p, lds, s & 7, 32 * (127 - (s >> 3)));
#endif
                } else { const int s = it - 1536; kmean_unit(p, lds, l, s >> 6, (s >> 4) & 3, s & 15); }
            }
        } else if (k == 3 && (PH_MASK & 8)) {
            for (;;) {
                const int it = next_item(lds, ctr + 16 * (2 * l + 1) + 64 * rep);
                if (it >= 1024) break;
                const int c = 15 - (it >> 6), bh = it & 31;
                if (((it >> 5) & 1) == 0) dsa_unit(p, lds, bh >> 2, bh & 3, c); else moba_unit(p, lds, l, bh >> 2, bh & 3, c);
            }
        } else if (k == 4 && (PH_MASK & 16)) {
            pg8::Gemm g{(const bf16_t*)p.out + (size_t)MTOK * DM, (const bf16_t*)(ws + WS_WO) + (size_t)l * DM * DM, MTOK, DM, DM};     pg8::StaticOrder S; S.init(MTOK, DM, gridDim.x, blockIdx.x);
            EpiRes E{nullptr, (l == 0) ? (const bf16_t*)XB : (const bf16_t*)p.out, nullptr, (bf16_t*)(ws + WS_SCR), (float*)(ws + WS_RSS) + (size_t)(2 * l + 1) * MTOK};
            pg8::gemm_phase<EpiRes, pg8::StaticOrder, true, true>(lds3, g, S, E);
        } else if (k == 5 && (PH_MASK & 32)) {
        } else if (k == 6 && (PH_MASK & 64)) {
            pg8::Gemm g{(const bf16_t*)(ws + WS_SCR), (const bf16_t*)(ws + WS_W3) + (size_t)l * 2 * DFF * DM, MTOK, 2 * DFF, DM}; pg8::StaticOrder S; S.init(MTOK, 2 * DFF, gridDim.x, blockIdx.x);
            EpiSwi E{(bf16_t*)(ws + WS_H), (const float*)(ws + WS_RSS) + (size_t)(2 * l + 1) * MTOK};
            pg8::gemm_phase<EpiSwi, pg8::StaticOrder, true, true>(lds3, g, S, E);
        } else if (PH_MASK & 128) {
            pg8::Gemm g{(const bf16_t*)(ws + WS_H), (const bf16_t*)(ws + WS_WD) + (size_t)l * DM * DFF, MTOK, DM, DFF}; pg8::StaticOrder S; S.init(MTOK, DM, gridDim.x, blockIdx.x);
            EpiRes E{nullptr, (const bf16_t*)(ws + WS_SCR), (l == 0) ? nullptr : p.out, (l == 0) ? (bf16_t*)p.out : nullptr, (l == 0) ? (float*)(ws + WS_RSS) + (size_t)2 * MTOK : nullptr};
            pg8::gemm_phase<EpiRes, pg8::StaticOrder, true, true>(lds3, g, S, E);
        }
        }
    }
}

#ifndef ONE_LAUNCH_X
#define ONE_LAUNCH 1
#endif
extern "C" void kernel_launch(void* const* d_in, const int* in_sizes, int n_in, void* d_out, int out_size, void* d_ws, size_t ws_size, hipStream_t stream) {
    static int grid = 0;
    if (grid == 0) {
        if (n_in != 12 || ws_size < WS_END) { fprintf(stderr, "kernel_launch: unexpected n_in %d / ws %zu\n", n_in, ws_size); grid = -1; return; }
        int dev = 0, cus = 0, per_cu = 0;
        hipGetDevice(&dev); hipDeviceGetAttribute(&cus, hipDeviceAttributeMultiprocessorCount, dev);
        if (hipFuncSetAttribute((const void*)mega_fwd, hipFuncAttributeMaxDynamicSharedMemorySize, LDS_BYTES) != hipSuccess) { fprintf(stderr, "hipFuncSetAttribute failed\n"); grid = -1; return; }
        hipOccupancyMaxActiveBlocksPerMultiprocessor(&per_cu, (const void*)mega_fwd, 512, LDS_BYTES);
        (void)hipGetLastError();
        if (per_cu < 1) per_cu = 1;
        grid = cus * per_cu; if (grid > 256) grid = 256;
    }
    if (grid < 0) return;
    hipMemsetAsync((char*)d_ws + WS_CTL, 0, CTL_BYTES, stream);
    Params p{};
    p.x = (const float*)d_in[0]; p.attn_g = (const float*)d_in[1]; p.w_in = (const float*)d_in[2]; p.qg = (const float*)d_in[3]; p.kg = (const float*)d_in[4];
    p.dlam = (const float*)d_in[5]; p.subln = (const float*)d_in[6]; p.w_out = (const float*)d_in[7]; p.ffn_g = (const float*)d_in[8];
    p.w_gate = (const float*)d_in[9]; p.w_up = (const float*)d_in[10]; p.w_down = (const float*)d_in[11];
    p.out = (float*)d_out; p.ws = (unsigned char*)d_ws;
#if ONE_LAUNCH
    p.ph_lo = 0; p.ph_hi = 16;
    void* args[] = {&p};
    hipError_t e = hipLaunchCooperativeKernel((const void*)mega_fwd, dim3(grid), dim3(512), args, LDS_BYTES, stream);
    if (e != hipSuccess) fprintf(stderr, "cooperative launch failed: %s (grid %d)\n", hipGetErrorString(e), grid);
#else
    for (int ph = 0; ph < 16; ++ph) {
        p.ph_lo = ph; p.ph_hi = ph + 1;
        hipLaunchKernelGGL(mega_fwd, dim3(grid), dim3(512), LDS_BYTES, stream, p);
    }
#endif
}
```

```cpp
#include <hip/hip_runtime.h>
#include <hip/hip_cooperative_groups.h>
#include <cstdio>
#include <cstdint>
#include <cmath>
namespace cg = cooperative_groups;

namespace pg8 {
#define PG8_LAS __attribute__((address_space(3)))
typedef unsigned short bf16_t;
typedef short bf16x8 __attribute__((ext_vector_type(8)));
typedef float f32x4 __attribute__((ext_vector_type(4)));
typedef unsigned u32x4 __attribute__((ext_vector_type(4)));
constexpr int BM = 256, BK = 64, HALF = 128, HTB = HALF * BK * 2  , STAGE_BYTES = 8 * HTB, NXCD = 8, WGM = 8;

__host__ __device__ __forceinline__ int lds_byte(int r, int c) { const int st = (r >> 4) * 2 + (c >> 5), rr = r & 15, cc = c & 31, ob = rr * 64 + cc * 2; return st * 1024 + (ob ^ (((ob >> 9) & 1) << 5)); }
__host__ __device__ __forceinline__ void stage_rc(int b, int& R, int& C) { const int st = b / 1024, sb = b % 1024, swz = sb ^ (((sb >> 9) & 1) << 5); R = (st >> 1) * 16 + swz / 64; C = (st & 1) * 32 + (swz % 64) / 2; }
__host__ __device__ __forceinline__ int perm32(int rho) { const int n = rho >> 4, i = rho & 15; return 8 * (i >> 2) + 4 * n + (i & 3); }

struct Unit { int pm, pn; };
struct Gemm { const bf16_t* A; const bf16_t* Bt; int M, N, K; };

struct StaticOrder {
    int nM, nN, nwg, G, c;
    __host__ __device__ void init(int M, int N, int G_, int c_) { nM = M / BM; nN = N / BM; nwg = nM * nN; G = G_; c = c_; }
    __host__ __device__ bool next(int i, Unit& u) const {
        const long L = (long)i * G + c; if (L >= nwg) return false;
        int wgid = (int)L; { const int q = nwg / NXCD, r = nwg % NXCD, xcd = wgid % NXCD, off = wgid / NXCD; wgid = (xcd < r ? xcd * (q + 1) : r * (q + 1) + (xcd - r) * q) + off; }
        const int nig = WGM * nN, gid = wgid / nig, fm = gid * WGM, gsz = (nM - fm) < WGM ? (nM - fm) : WGM;
        u.pm = fm + ((wgid % nig) % gsz); u.pn = (wgid % nig) / gsz; return true;
    }
    __device__ __forceinline__ void a_ready(const Unit&) const {}
    __device__ __forceinline__ void done(const Unit&) const {}
};

__device__ __forceinline__ unsigned cvt_pk_bf16(float lo, float hi) { unsigned r; asm volatile("v_cvt_pk_bf16_f32 %0, %1, %2" : "=v"(r) : "v"(lo), "v"(hi)); return r; }
typedef float f32x2 __attribute__((ext_vector_type(2)));
template <class Epi, class Sched, bool ALIGN_EPI = false, bool SP2 = false>
__device__ __forceinline__ void gemm_phase(PG8_LAS unsigned char* lds, const Gemm g, const Sched& S, const Epi& E) {
    int tid_ = threadIdx.x; asm volatile("" : "+v"(tid_) :: "memory");
    const int tid = tid_, wid = __builtin_amdgcn_readfirstlane(tid >> 6), lane = tid & 63, wr = wid >> 2, wc = wid & 3, fr = lane & 15, fq = lane >> 4;
    const int K = g.K, nt = K / BK;
    unsigned voffA[2], voffB[2];
#pragma unroll
    for (int i = 0; i < 2; ++i) { int R, C; stage_rc(tid * 16 + i * 8192, R, C); const int Rb = Epi::PERM ? ((R & ~31) + perm32(R & 31)) : R;
        voffA[i] = (unsigned)(R * K + C) * 2u; voffB[i] = (unsigned)(Rb * K + C) * 2u; }
    const size_t kstep = (size_t)(BK * 2);
    const size_t hstep = (size_t)HALF * K * 2;
    const size_t tstep = 2 * hstep;
    const unsigned ldsw = (unsigned)wid * 1024u;
    const int aoff = lds_byte(wr * 64 + fr, fq * 8), boff = lds_byte(wc * 32 + fr, fq * 8);
#define PG8_SA(b, h) (((b) * 2 + (h)) * HTB)
#define PG8_SB(b, h) ((4 + (b) * 2 + (h)) * HTB)
#define PG8_STAGE(bufoff, gbase, voff) do { _Pragma("unroll") for (int _i = 0; _i < 2; ++_i) \
        __builtin_amdgcn_global_load_lds((const unsigned*)((const char*)(gbase) + (voff)[_i]), (PG8_LAS unsigned*)(lds + (bufoff) + ldsw + _i * 8192), 16, 0, 0); } while (0)
#define PG8_LDA(dst, b, h) do { _Pragma("unroll") for (int m = 0; m < 4; ++m) _Pragma("unroll") for (int k = 0; k < 2; ++k) dst[m][k] = *(const PG8_LAS bf16x8*)(lds + PG8_SA(b, h) + aoff + m * 2048 + k * 1024); } while (0)
#define PG8_LDB(dst, b, h) do { _Pragma("unroll") for (int n = 0; n < 2; ++n) _Pragma("unroll") for (int k = 0; k < 2; ++k) dst[n][k] = *(const PG8_LAS bf16x8*)(lds + PG8_SB(b, h) + boff + n * 2048 + k * 1024); } while (0)
#define PG8_MMA(ai, bj, At, Bt) do { __builtin_amdgcn_s_setprio(1); _Pragma("unroll") for (int m = 0; m < 4; ++m) _Pragma("unroll") for (int n = 0; n < 2; ++n) _Pragma("unroll") for (int k = 0; k < 2; ++k) \
        acc[ai][bj][m][n] = __builtin_amdgcn_mfma_f32_16x16x32_bf16(Bt[n][k], At[m][k], acc[ai][bj][m][n], 0, 0, 0); __builtin_amdgcn_s_setprio(0); } while (0)
#define PG8_WAIT_V(n) asm volatile("s_waitcnt vmcnt(" #n ")" ::: "memory")
#define PG8_WAIT_L(n) asm volatile("s_waitcnt lgkmcnt(" #n ")" ::: "memory")
#define PG8_BAR __builtin_amdgcn_s_barrier()
#define PG8_SCHED __builtin_amdgcn_sched_barrier(0)
    Unit cur, nxt; int ui = 0;
    if (!S.next(0, cur)) return;
    f32x4 acc[2][2][4][2];
#pragma unroll
    for (int a = 0; a < 2; ++a)
#pragma unroll
        for (int b = 0; b < 2; ++b)
#pragma unroll
            for (int m = 0; m < 4; ++m)
#pragma unroll
                for (int n = 0; n < 2; ++n) acc[a][b][m][n] = (f32x4){0.f, 0.f, 0.f, 0.f};
    bf16x8 At[4][2], B0[2][2], B1[2][2];
    const char* cA = (const char*)g.A + (size_t)cur.pm * tstep; const char* cB = (const char*)g.Bt + (size_t)cur.pn * tstep;
    S.a_ready(cur);
    if constexpr (SP2) {
        PG8_STAGE(PG8_SB(0, 0), cB, voffB); PG8_STAGE(PG8_SB(0, 1), cB + hstep, voffB); PG8_STAGE(PG8_SA(0, 0), cA, voffA); PG8_STAGE(PG8_SA(0, 1), cA + hstep, voffA);
        if (wr == 1) PG8_BAR;
        PG8_WAIT_V(2); PG8_BAR;
        PG8_STAGE(PG8_SB(1, 0), cB + kstep, voffB); PG8_STAGE(PG8_SA(1, 0), cA + kstep, voffA); PG8_STAGE(PG8_SB(1, 1), cB + hstep + kstep, voffB);
        PG8_WAIT_V(6); PG8_BAR;
    } else {
        PG8_STAGE(PG8_SB(0, 0), cB, voffB); PG8_STAGE(PG8_SA(0, 0), cA, voffA); PG8_STAGE(PG8_SB(0, 1), cB + hstep, voffB); PG8_STAGE(PG8_SA(0, 1), cA + hstep, voffA);
        if (wr == 1) PG8_BAR;
        PG8_WAIT_V(4); PG8_BAR;
        PG8_STAGE(PG8_SB(1, 0), cB + kstep, voffB); PG8_STAGE(PG8_SA(1, 0), cA + kstep, voffA); PG8_STAGE(PG8_SB(1, 1), cB + hstep + kstep, voffB);
        PG8_WAIT_V(6); PG8_BAR;
    }
    for (;;) {
        const bool has_next = S.next(ui + 1, nxt);
        const char* nA = has_next ? (const char*)g.A + (size_t)nxt.pm * tstep : cA; const char* nB = has_next ? (const char*)g.Bt + (size_t)nxt.pn * tstep : cB;
        for (int t = 0; t < nt; t += 2) {
            const bool last = (t == nt - 2);
            const char* a1 = cA + (size_t)(t + 1) * kstep;
            const char* a2 = last ? nA : cA + (size_t)(t + 2) * kstep; const char* b2 = last ? nB : cB + (size_t)(t + 2) * kstep;
            const char* a3 = a2 + kstep; const char* b3 = b2 + kstep;
            if (last && has_next) S.a_ready(nxt);
            if constexpr (SP2) {
            PG8_LDB(B0, 0, 0); PG8_LDB(B1, 0, 1); PG8_SCHED; PG8_LDA(At, 0, 0); PG8_STAGE(PG8_SA(1, 1), a1 + hstep, voffA);
            PG8_WAIT_V(8); PG8_WAIT_L(0); PG8_BAR; PG8_MMA(0, 0, At, B0); PG8_MMA(0, 1, At, B1); PG8_BAR; PG8_SCHED;
            PG8_LDA(At, 0, 1); PG8_STAGE(PG8_SB(0, 0), b2, voffB); PG8_STAGE(PG8_SB(0, 1), b2 + hstep, voffB); PG8_STAGE(PG8_SA(0, 0), a2, voffA);
            PG8_WAIT_V(8); PG8_WAIT_L(0); PG8_BAR; PG8_MMA(1, 0, At, B0); PG8_MMA(1, 1, At, B1); PG8_BAR; PG8_SCHED;
            PG8_LDB(B0, 1, 0); PG8_LDB(B1, 1, 1); PG8_SCHED; PG8_LDA(At, 1, 0); PG8_STAGE(PG8_SA(0, 1), a2 + hstep, voffA);
            PG8_WAIT_V(8); PG8_WAIT_L(0); PG8_BAR; PG8_MMA(0, 0, At, B0); PG8_MMA(0, 1, At, B1); PG8_BAR; PG8_SCHED;
            PG8_LDA(At, 1, 1); PG8_STAGE(PG8_SB(1, 0), b3, voffB); PG8_STAGE(PG8_SB(1, 1), b3 + hstep, voffB); PG8_STAGE(PG8_SA(1, 0), a3, voffA);
            PG8_WAIT_V(8); PG8_WAIT_L(0); PG8_BAR; PG8_MMA(1, 0, At, B0); PG8_MMA(1, 1, At, B1); PG8_BAR; PG8_SCHED;
            } else {
            PG8_LDB(B0, 0, 0); PG8_SCHED; PG8_LDA(At, 0, 0); PG8_STAGE(PG8_SA(1, 1), a1 + hstep, voffA);
            PG8_WAIT_L(8); PG8_BAR; PG8_WAIT_L(0); PG8_MMA(0, 0, At, B0); PG8_BAR; PG8_SCHED;
            PG8_LDB(B1, 0, 1); PG8_STAGE(PG8_SB(0, 0), b2, voffB);
            PG8_BAR; PG8_WAIT_L(0); PG8_MMA(0, 1, At, B1); PG8_BAR;
            PG8_LDA(At, 0, 1); PG8_STAGE(PG8_SA(0, 0), a2, voffA);
            PG8_BAR; PG8_WAIT_L(0); PG8_MMA(1, 0, At, B0); PG8_BAR; PG8_SCHED;
            PG8_STAGE(PG8_SB(0, 1), b2 + hstep, voffB);
            PG8_WAIT_V(6); PG8_BAR; PG8_MMA(1, 1, At, B1); PG8_BAR;
            PG8_LDB(B0, 1, 0); PG8_SCHED; PG8_LDA(At, 1, 0); PG8_STAGE(PG8_SA(0, 1), a2 + hstep, voffA);
            PG8_WAIT_L(8); PG8_BAR; PG8_WAIT_L(0); PG8_MMA(0, 0, At, B0); PG8_BAR; PG8_SCHED;
            PG8_LDB(B1, 1, 1); PG8_STAGE(PG8_SB(1, 0), b3, voffB);
            PG8_BAR; PG8_WAIT_L(0); PG8_MMA(0, 1, At, B1); PG8_BAR;
            PG8_LDA(At, 1, 1); PG8_STAGE(PG8_SA(1, 0), a3, voffA);
            PG8_BAR; PG8_WAIT_L(0); PG8_MMA(1, 0, At, B0); PG8_BAR; PG8_SCHED;
            PG8_STAGE(PG8_SB(1, 1), b3 + hstep, voffB);
            PG8_WAIT_V(6); PG8_BAR; PG8_MMA(1, 1, At, B1); PG8_BAR;
            }
        }
        if constexpr (ALIGN_EPI) { if (wr == 0) PG8_BAR; }
        if constexpr (!Epi::AFTER_DRAIN) { E(acc, cur, wr, wc, fr, fq); S.done(cur); }
        if (!has_next) break;
#pragma unroll
        for (int a = 0; a < 2; ++a)
#pragma unroll
            for (int b = 0; b < 2; ++b)
#pragma unroll
                for (int m = 0; m < 4; ++m)
#pragma unroll
                    for (int n = 0; n < 2; ++n) acc[a][b][m][n] = (f32x4){0.f, 0.f, 0.f, 0.f};
        cur = nxt; cA = nA; cB = nB; ++ui;
        if constexpr (ALIGN_EPI) { if (wr == 1) PG8_BAR; }
    }
    PG8_WAIT_V(0);
    if constexpr (!ALIGN_EPI) { if (wr == 0) PG8_BAR; }
    PG8_BAR;
    if constexpr (Epi::AFTER_DRAIN) { E.fused(acc, cur, wr, wc, fr, fq, lds, wid, lane); S.done(cur); }
#undef PG8_SA
#undef PG8_SB
#undef PG8_STAGE
#undef PG8_LDA
#undef PG8_LDB
#undef PG8_MMA
#undef PG8_WAIT_V
#undef PG8_WAIT_L
#undef PG8_BAR
#undef PG8_SCHED
}
}

#ifndef PH_MASK
#define PH_MASK 255
#endif
#ifndef REP_SKIP_DIFF
#define REP_SKIP_DIFF 1
#endif
#ifndef SEL_REP_SCORE
#define SEL_REP_SCORE 1
#endif
#ifndef SEL_REP_ROWS
#define SEL_REP_ROWS 1
#endif
#ifndef EXTRA_SYNCS
#define EXTRA_SYNCS 0
#endif
#ifndef PROBE_XATOM
#define PROBE_XATOM 0
#endif
#ifndef REP_MASK
#define REP_MASK 0
#endif
#ifndef ONE_LAUNCH
#define ONE_LAUNCH 1
#endif
typedef unsigned short bf16_t;
typedef short bf16x8 __attribute__((ext_vector_type(8)));
typedef short s16x4 __attribute__((ext_vector_type(4)));
typedef float f32x4 __attribute__((ext_vector_type(4)));
typedef float f32x16 __attribute__((ext_vector_type(16)));
typedef unsigned u32x4 __attribute__((ext_vector_type(4)));
typedef unsigned u32x2 __attribute__((ext_vector_type(2)));
typedef __bf16 bf16x2_t __attribute__((ext_vector_type(2)));
typedef float f32x2_t __attribute__((ext_vector_type(2)));
typedef unsigned long long u64;
#define DI __device__ __forceinline__
#define LAS __attribute__((address_space(3)))
#define GAS __attribute__((address_space(1)))
#define MFMA32(a, b, c) __builtin_amdgcn_mfma_f32_32x32x16_bf16((a), (b), (c), 0, 0, 0)
#define NEG_INF (-__builtin_inff())

constexpr int SEQ = 4096, BATCH = 8, DM = 1024, MTOK = BATCH * SEQ, DFF = 2816, INC = 3656;
constexpr int N1A = 2816;
constexpr int NSLOT = 41;
constexpr float EPS = 1e-6f;
constexpr size_t MiB = 1u << 20;
constexpr size_t WS_CTL = 0, CTL_BYTES = 1 * MiB;
constexpr int CW_BAR = 4096;
constexpr size_t WS_KMEAN = 65536;
constexpr size_t WS_RSS = 512 * 1024;
constexpr size_t WS_CS = 1 * MiB;
constexpr size_t WS_IW = 2 * MiB;
constexpr size_t WS_W1A = 4 * MiB, WS_W1B = 15 * MiB, WS_WO = 19 * MiB, WS_W3 = 23 * MiB, WS_WD = 45 * MiB;
constexpr size_t WS_BM = 56 * MiB;
constexpr size_t WS_XB = 72 * MiB;
constexpr size_t WS_QK = 136 * MiB;
constexpr size_t WS_VT = 300 * MiB;
constexpr size_t WS_H = 136 * MiB;
constexpr size_t WS_SCR = 364 * MiB;
constexpr size_t WS_END = 492 * MiB;
constexpr int LDS_BYTES = 147456;

DI unsigned pk2(float lo, float hi) { f32x2_t v = {lo, hi}; bf16x2_t b = __builtin_convertvector(v, bf16x2_t); return __builtin_bit_cast(unsigned, b); }
DI float bf_lo(unsigned u) { return __builtin_bit_cast(float, u << 16); }
DI float bf_hi(unsigned u) { return __builtin_bit_cast(float, u & 0xffff0000u); }
DI int opaque_tid() { int t = threadIdx.x; asm volatile("" : "+v"(t)); return t; }
template <class T> DI T* gp(T* p) { return (T*)(__attribute__((address_space(1))) T*)p; }
DI int crow(int r, int h) { return (r & 3) + 8 * (r >> 2) + 4 * h; }
DI float shx(float v, int m, int lane) { return __builtin_bit_cast(float, __builtin_amdgcn_ds_bpermute((lane ^ m) << 2, __builtin_bit_cast(int, v))); }
DI float wave_sum(float v, int lane) {
#pragma unroll
    for (int o = 1; o < 64; o <<= 1) v += shx(v, o, lane);
    return v;
}

struct Params {
    const float* x; const float* attn_g; const float* w_in; const float* qg; const float* kg; const float* dlam; const float* subln;
    const float* w_out; const float* ffn_g; const float* w_gate; const float* w_up; const float* w_down;
    float* out; unsigned char* ws;
    int ph_lo, ph_hi;
};

struct EpiQK {
    static constexpr bool PERM = true, AFTER_DRAIN = false;
    bf16_t* QK; float* iw; const float* cs; const float* qg; const float* kg; const float* rss;
    DI void head(const pg8::f32x4 (&acc)[2][2][4][2], int row0, int fq, int lane, const float* g, bf16_t* dst) const {
        const bool norm = (g != nullptr);
        f32x4 g00 = {1.f, 1.f, 1.f, 1.f}, g01 = g00, g10 = g00, g11 = g00;
        if (norm) { g00 = *(const f32x4*)(g + 8 * fq); g01 = *(const f32x4*)(g + 8 * fq + 4); g10 = *(const f32x4*)(g + 32 + 8 * fq); g11 = *(const f32x4*)(g + 32 + 8 * fq + 4); }
        f32x4 nc0, nc1, ns0, ns1; float nrs;
        { const int row = row0, pos = row & (SEQ - 1); const float* cp = cs + (size_t)pos * 64 + 8 * fq;
          nc0 = *(const f32x4*)(cp); nc1 = *(const f32x4*)(cp + 4); ns0 = *(const f32x4*)(cp + 32); ns1 = *(const f32x4*)(cp + 36); nrs = rss[row]; }
#pragma unroll
        for (int idx = 0; idx < 8; ++idx) {
                const int ai = idx >> 2, m = idx & 3;
                const int row = row0 + ai * 128 + m * 16;
                const f32x4 c0 = nc0, c1 = nc1, s0 = ns0, s1 = ns1; const float rsv = nrs;
                if (idx < 7) { const int nrow = row0 + ((idx + 1) >> 2) * 128 + ((idx + 1) & 3) * 16, npos = nrow & (SEQ - 1); const float* cp = cs + (size_t)npos * 64 + 8 * fq;
                    nc0 = *(const f32x4*)(cp); nc1 = *(const f32x4*)(cp + 4); ns0 = *(const f32x4*)(cp + 32); ns1 = *(const f32x4*)(cp + 36); nrs = rss[nrow]; }
                const float rr = rsqrtf(rsv * (1.f / DM) + EPS);
                f32x4 a00 = acc[ai][0][m][0] * rr, a01 = acc[ai][0][m][1] * rr, a10 = acc[ai][1][m][0] * rr, a11 = acc[ai][1][m][1] * rr;
                {
                    f32x4 sq = a00 * a00 + a01 * a01 + a10 * a10 + a11 * a11;
                    float ss = (sq[0] + sq[1]) + (sq[2] + sq[3]);
                    ss += shx(ss, 16, lane); ss += shx(ss, 32, lane);
                    const float rn = norm ? rsqrtf(ss * (1.f / 64.f) + EPS) : 1.f;
                    a00 = a00 * rn * g00; a01 = a01 * rn * g01; a10 = a10 * rn * g10; a11 = a11 * rn * g11;
                }
                const f32x4 o00 = a00 * c0 - a10 * s0, o01 = a01 * c1 - a11 * s1, o10 = a00 * s0 + a10 * c0, o11 = a01 * s1 + a11 * c1;
                u32x4 w0, w1;
                w0[0] = pk2(o00[0], o00[1]); w0[1] = pk2(o00[2], o00[3]); w0[2] = pk2(o01[0], o01[1]); w0[3] = pk2(o01[2], o01[3]);
                w1[0] = pk2(o10[0], o10[1]); w1[1] = pk2(o10[2], o10[3]); w1[2] = pk2(o11[0], o11[1]); w1[3] = pk2(o11[2], o11[3]);
                bf16_t* dp = dst + (size_t)row * 64 + 8 * fq;
                *(u32x4*)dp = w0; *(u32x4*)(dp + 32) = w1;
                __builtin_amdgcn_sched_barrier(0);
        }
    }
    DI void operator()(const pg8::f32x4 (&acc)[2][2][4][2], const pg8::Unit& u, int wr, int wc, int fr, int fq) const {
        const int T = u.pn, row0 = u.pm * 256 + wr * 64 + fr;
        if (T == 10 && wc == 1) {
            if (fq == 0) {
#pragma unroll
                for (int ai = 0; ai < 2; ++ai)
#pragma unroll
                    for (int m = 0; m < 4; ++m) {
                        const int row = row0 + ai * 128 + m * 16;
                        const float sc = 0.35355339059f * 0.125f * rsqrtf(rss[row] * (1.f / DM) + EPS);
                        f32x4 a = acc[ai][0][m][0], b = acc[ai][0][m][1];
                        *(f32x4*)(iw + (size_t)row * 8) = a * sc; *(f32x4*)(iw + (size_t)row * 8 + 4) = b * sc;
                    }
            }
            return;
        }
        if (T == 10 && wc > 1) return;
        const int slot = (T == 10) ? 40 : T * 4 + wc;
        const float* g = (T == 0) ? qg : (T == 1) ? kg : (T <= 3) ? qg + 64 : (T <= 5) ? kg + 64 : (T == 6) ? qg + 128 : (T == 7) ? kg + 128 : nullptr;
        head(acc, row0, fq, fr + 16 * fq, g, QK + (size_t)slot * MTOK * 64);
    }
};
struct EpiVT {
    static constexpr bool PERM = true, AFTER_DRAIN = false;
    bf16_t* O; int ldc; const float* rss;
    DI void operator()(const pg8::f32x4 (&acc)[2][2][4][2], const pg8::Unit& u, int wr, int wc, int fr, int fq) const {
        const int row0 = u.pm * 256 + wr * 64 + fr, col0 = u.pn * 256 + wc * 32 + 8 * fq;
        f32x4 r0[2], r1[2];
#pragma unroll
        for (int bj = 0; bj < 2; ++bj) { const f32x4 s0 = *(const f32x4*)(rss + col0 + bj * 128), s1 = *(const f32x4*)(rss + col0 + bj * 128 + 4);
#pragma unroll
            for (int e = 0; e < 4; ++e) { r0[bj][e] = rsqrtf(s0[e] * (1.f / DM) + EPS); r1[bj][e] = rsqrtf(s1[e] * (1.f / DM) + EPS); } }
#pragma unroll
        for (int ai = 0; ai < 2; ++ai)
#pragma unroll
            for (int m = 0; m < 4; ++m) {
                bf16_t* rp = O + (size_t)(row0 + ai * 128 + m * 16) * ldc + col0;
#pragma unroll
                for (int bj = 0; bj < 2; ++bj) {
                    const f32x4 v0 = acc[ai][bj][m][0] * r0[bj], v1 = acc[ai][bj][m][1] * r1[bj];
                    u32x4 w; w[0] = pk2(v0[0], v0[1]); w[1] = pk2(v0[2], v0[3]); w[2] = pk2(v1[0], v1[1]); w[3] = pk2(v1[2], v1[3]);
                    *(u32x4*)(rp + bj * 128) = w;
                }
            }
    }
};
struct EpiRes {
    static constexpr bool PERM = true, AFTER_DRAIN = false;
    const float* srcf; const bf16_t* srcb; float* out; bf16_t* xb; float* rss;
    DI void operator()(const pg8::f32x4 (&acc)[2][2][4][2], const pg8::Unit& u, int wr, int wc, int fr, int fq) const {
        const int row0 = u.pm * 256 + wr * 64 + fr, col0 = u.pn * 256 + wc * 32 + 8 * fq, lane = fr + 16 * fq;
#pragma unroll
        for (int ai = 0; ai < 2; ++ai)
#pragma unroll
            for (int m = 0; m < 4; ++m) {
                const int row = row0 + ai * 128 + m * 16;
                const size_t off = (size_t)row * DM + col0;
                float ss = 0.f;
#pragma unroll
                for (int bj = 0; bj < 2; ++bj) {
                    f32x4 x0, x1;
                    if (srcb) { const u32x4 w = *(const u32x4*)(srcb + off + bj * 128);
                        x0 = (f32x4){bf_lo(w[0]), bf_hi(w[0]), bf_lo(w[1]), bf_hi(w[1])}; x1 = (f32x4){bf_lo(w[2]), bf_hi(w[2]), bf_lo(w[3]), bf_hi(w[3])}; }
                    else { x0 = *(const f32x4*)(srcf + off + bj * 128); x1 = *(const f32x4*)(srcf + off + bj * 128 + 4); }
                    x0 = x0 + acc[ai][bj][m][0]; x1 = x1 + acc[ai][bj][m][1];
                    if (out) { *(f32x4*)(out + off + bj * 128) = x0; *(f32x4*)(out + off + bj * 128 + 4) = x1; }
                    if (xb) { u32x4 w; w[0] = pk2(x0[0], x0[1]); w[1] = pk2(x0[2], x0[3]); w[2] = pk2(x1[0], x1[1]); w[3] = pk2(x1[2], x1[3]); *(u32x4*)(xb + off + bj * 128) = w; }
                    const f32x4 sq = x0 * x0 + x1 * x1; ss += (sq[0] + sq[1]) + (sq[2] + sq[3]);
                }
                if (rss) { ss += shx(ss, 16, lane); ss += shx(ss, 32, lane); if (fq == 0) atomicAdd(rss + row, ss); }
            }
    }
};
struct EpiSwi {
    static constexpr bool PERM = true, AFTER_DRAIN = false;
    bf16_t* H; const float* rss;
    DI void operator()(const pg8::f32x4 (&acc)[2][2][4][2], const pg8::Unit& u, int wr, int wc, int fr, int fq) const {
        const int row0 = u.pm * 256 + wr * 64 + fr, col0 = u.pn * 128 + wc * 32 + 8 * fq;
        float rsv[8];
#pragma unroll
        for (int e = 0; e < 8; ++e) rsv[e] = rss[row0 + (e >> 2) * 128 + (e & 3) * 16];
#pragma unroll
        for (int ai = 0; ai < 2; ++ai)
#pragma unroll
            for (int m = 0; m < 4; ++m) {
                float hv[8];
                const float rr = rsqrtf(rsv[4 * ai + m] * (1.f / DM) + EPS);
#pragma unroll
                for (int n = 0; n < 2; ++n)
#pragma unroll
                    for (int j = 0; j < 4; ++j) {
                        const float g = acc[ai][0][m][n][j] * rr, up = acc[ai][1][m][n][j] * rr;
                        hv[4 * n + j] = g * up * __builtin_amdgcn_rcpf(1.f + __builtin_amdgcn_exp2f(-1.44269504089f * g));
                    }
                u32x4 w; w[0] = pk2(hv[0], hv[1]); w[1] = pk2(hv[2], hv[3]); w[2] = pk2(hv[4], hv[5]); w[3] = pk2(hv[6], hv[7]);
                *(u32x4*)(H + (size_t)(row0 + ai * 128 + m * 16) * DFF + col0) = w;
            }
    }
};

DI void wconv_item(const float* W, int N, int col0, int nvalid, const float* gk, bf16_t* WT, int K, int n0, int k0, LAS float* scr, int lane) {
    const int c = lane & 31;
    const int cc = (c < nvalid) ? c : 0;
    float wv[32], gv[32];
#pragma unroll
    for (int i = 0; i < 32; ++i) { const int kk = 2 * i + (lane >> 5); wv[i] = W[(size_t)(k0 + kk) * N + col0 + cc]; gv[i] = gk ? gk[k0 + kk] : 1.f; }
#pragma unroll
    for (int i = 0; i < 32; ++i) { const int kk = 2 * i + (lane >> 5); scr[kk * 33 + c] = (c < nvalid) ? wv[i] * gv[i] : 0.f; }
    asm volatile("s_waitcnt lgkmcnt(0)" ::: "memory");
    const int ch = lane & 7;
#pragma unroll
    for (int j = 0; j < 4; ++j) {
        const int n = (lane >> 3) + 8 * j; const LAS float* s = scr + (8 * ch) * 33 + n;
        u32x4 o; o[0] = pk2(s[0], s[33]); o[1] = pk2(s[2 * 33], s[3 * 33]); o[2] = pk2(s[4 * 33], s[5 * 33]); o[3] = pk2(s[6 * 33], s[7 * 33]);
        *(u32x4*)(WT + (size_t)(n0 + n) * K + k0 + 8 * ch) = o;
    }
    asm volatile("s_waitcnt lgkmcnt(0)" ::: "memory");
}
DI void map_w1a(int n0, int& col0, int& nvalid) {
    const int T = n0 >> 8, c = n0 & 255, bj = c >> 7, wc = (c >> 5) & 3, d0 = 32 * bj;
    nvalid = 32;
    if (T == 10) { if (wc == 0) col0 = 3584 + d0; else if (wc == 1 && bj == 0) { col0 = 3648; nvalid = 8; } else { col0 = 0; nvalid = 0; } return; }
    const int s = T * 4 + wc;
    int base;
    if (s < 4) base = 0 + 64 * s; else if (s < 8) base = 256 + 64 * (s - 4); else if (s < 16) base = 768 + 64 * (s - 8); else if (s < 24) base = 1280 + 64 * (s - 16);
    else if (s < 28) base = 2304 + 64 * (s - 24); else if (s < 32) base = 2560 + 64 * (s - 28); else base = 3072 + 64 * (s - 32);
    col0 = base + d0;
}
DI void prologue_weights(const Params& p, unsigned char* lds) {
    const int tid = opaque_tid(), lane = tid & 63, wave = __builtin_amdgcn_readfirstlane(tid >> 6);
    LAS float* scr = (LAS float*)((LAS unsigned char*)lds) + wave * (64 * 33);
    const int gw = blockIdx.x * 8 + wave, NGW = gridDim.x * 8;
    constexpr int I1A = 88 * 16, I1B = 32 * 16, IO = 32 * 16, I3 = 176 * 16, ID = 32 * 44, IL = I1A + I1B + IO + I3 + ID;
    unsigned char* ws = p.ws;
    for (int it = gw; it < 2 * IL; it += NGW) {
        const int l = it / IL; int r = it - l * IL;
        if (r < I1A) { const int n0 = (r >> 4) * 32, k0 = (r & 15) * 64; int col0, nv; map_w1a(n0, col0, nv);
            wconv_item(p.w_in + (size_t)l * DM * INC, INC, col0, nv, p.attn_g + l * DM, (bf16_t*)(ws + WS_W1A) + (size_t)l * N1A * DM, DM, n0, k0, scr, lane); continue; }
        r -= I1A;
        if (r < I1B) { const int n0 = (r >> 4) * 32, k0 = (r & 15) * 64;
            const int col0 = n0 < 256 ? 512 + n0 : n0 < 768 ? 1792 + (n0 - 256) : 2816 + (n0 - 768);
            wconv_item(p.w_in + (size_t)l * DM * INC, INC, col0, 32, p.attn_g + l * DM, (bf16_t*)(ws + WS_W1B) + (size_t)l * DM * DM, DM, n0, k0, scr, lane); continue; }
        r -= I1B;
        if (r < IO) { const int n0 = (r >> 4) * 32, k0 = (r & 15) * 64;
            wconv_item(p.w_out + (size_t)l * DM * DM, DM, n0, 32, nullptr, (bf16_t*)(ws + WS_WO) + (size_t)l * DM * DM, DM, n0, k0, scr, lane); continue; }
        r -= IO;
        if (r < I3) { const int n0 = (r >> 4) * 32, k0 = (r & 15) * 64; const int T = n0 >> 8, c = n0 & 255, bj = c >> 7, cc = c & 127;
            const float* W = (bj ? p.w_up : p.w_gate) + (size_t)l * DM * DFF;
            wconv_item(W, DFF, 128 * T + cc, 32, p.ffn_g + l * DM, (bf16_t*)(ws + WS_W3) + (size_t)l * 2 * DFF * DM, DM, n0, k0, scr, lane); continue; }
        r -= I3;
        { const int n0 = (r / 44) * 32, k0 = (r % 44) * 64;
            wconv_item(p.w_down + (size_t)l * DFF * DM, DM, n0, 32, nullptr, (bf16_t*)(ws + WS_WD) + (size_t)l * DM * DFF, DFF, n0, k0, scr, lane); }
    }
    float* cs = (float*)(ws + WS_CS);
    for (int e = blockIdx.x * 512 + tid; e < SEQ * 32; e += gridDim.x * 512) {
        const int pos = e >> 5, i = e & 31;
        const float inv = 1.0f / exp2f((float)i * (13.287712379549449f / 32.f));
        const float ang = (float)pos * inv;
        double t = (double)ang * 0.15915494309189535; t -= __builtin_rint(t);
        const float f = (float)t;
        cs[pos * 64 + i] = __builtin_amdgcn_cosf(f); cs[pos * 64 + 32 + i] = __builtin_amdgcn_sinf(f);
    }
}
DI void norm_rows(const float* src, bf16_t* dst, float* rss) {
    const int tid = opaque_tid(), lane = tid & 63, wave = __builtin_amdgcn_readfirstlane(tid >> 6);
    const int gw = blockIdx.x * 8 + wave, NGW = gridDim.x * 8;
    for (int m = gw; m < MTOK; m += 2 * NGW) {
        const int m2 = (m + NGW < MTOK) ? m + NGW : m;
        const f32x4* xa = (const f32x4*)(src + (size_t)m * DM) + lane; const f32x4* xb2 = (const f32x4*)(src + (size_t)m2 * DM) + lane;
        f32x4 va[4], vb[4]; float sa = 0.f, sb = 0.f;
#pragma unroll
        for (int j = 0; j < 4; ++j) { va[j] = xa[64 * j]; vb[j] = xb2[64 * j]; }
#pragma unroll
        for (int j = 0; j < 4; ++j) { sa += (va[j][0] * va[j][0] + va[j][1] * va[j][1]) + (va[j][2] * va[j][2] + va[j][3] * va[j][3]); sb += (vb[j][0] * vb[j][0] + vb[j][1] * vb[j][1]) + (vb[j][2] * vb[j][2] + vb[j][3] * vb[j][3]); }
        sa = wave_sum(sa, lane); sb = wave_sum(sb, lane);
        if (lane == 0) { rss[m] = sa; rss[m2] = sb; }
        u32x2* oa = (u32x2*)(dst + (size_t)m * DM) + lane; u32x2* ob = (u32x2*)(dst + (size_t)m2 * DM) + lane;
#pragma unroll
        for (int j = 0; j < 4; ++j) { u32x2 w; w[0] = pk2(va[j][0], va[j][1]); w[1] = pk2(va[j][2], va[j][3]); oa[64 * j] = w; u32x2 w2; w2[0] = pk2(vb[j][0], vb[j][1]); w2[1] = pk2(vb[j][2], vb[j][3]); ob[64 * j] = w2; }
    }
}

constexpr int ROWB = 144, VROWB = 264, KS_BYTES = 128 * ROWB, VS_BYTES = 128 * VROWB;
constexpr int LDS_KS = 0, LDS_VS = 2 * KS_BYTES, LDS_TOP = LDS_VS + 3 * VS_BYTES;
constexpr int LDS_BST = LDS_TOP + 64, LDS_MISC = LDS_TOP + 128, LDS_QM = LDS_TOP + 256;
static_assert(LDS_TOP >= 131072 && LDS_QM + 1024 <= 147456, "LDS map");
constexpr float SM_C = 0.125f * 1.44269504089f;

template <int DV, int MODE>
DI void flash_pass(unsigned char* lds, const bf16_t* __restrict__ Qp, const bf16_t* __restrict__ Kp, const bf16_t* __restrict__ VTp, int q0,
                   f32x16 (&o)[DV / 32], float& m_run, float& l_run, unsigned qmask, unsigned umask, const u64* bmrow) {
    const int tid = opaque_tid(), lane = tid & 63, wave = __builtin_amdgcn_readfirstlane(tid >> 6), h = lane >> 5, ql = lane & 31;
    const int qw0 = q0 + 32 * wave, q = qw0 + ql;
    bf16x8 qf[4];
#pragma unroll
    for (int ks = 0; ks < 4; ++ks) qf[ks] = *(const GAS bf16x8*)(Qp + (size_t)q * 64 + 16 * ks + 8 * h);
#pragma unroll
    for (int dt = 0; dt < DV / 32; ++dt)
#pragma unroll
        for (int i = 0; i < 16; ++i) o[dt][i] = 0.f;
    m_run = NEG_INF; l_run = 0.f;
    const int ntile = (q0 + 256) >> 7;
    const int krow = tid >> 3, kch = tid & 7;
    const int vrow = tid >> 4, vch = tid & 15;
    int j = 0;
    if (MODE == 1) { while (j < ntile && !((umask >> (j >> 1)) & 1u)) j += 2; }
    u32x4 kreg[2]; u32x4 vreg[DV / 32]; u64 mreg0 = 0, mreg1 = 0;
    kreg[0] = (u32x4){0u, 0u, 0u, 0u}; kreg[1] = kreg[0];
#pragma unroll
    for (int i = 0; i < DV / 32; ++i) vreg[i] = kreg[0];
#define FL_LOADT(jj) do { const int k0_ = (jj) * 128; \
        kreg[0] = *(const GAS u32x4*)(Kp + (size_t)(k0_ + krow) * 64 + kch * 8); kreg[1] = *(const GAS u32x4*)(Kp + (size_t)(k0_ + 64 + krow) * 64 + kch * 8); \
        _Pragma("unroll") for (int i_ = 0; i_ < DV / 32; ++i_) vreg[i_] = *(const GAS u32x4*)(VTp + (size_t)(vrow + 32 * i_) * MTOK + k0_ + vch * 8); \
        if (MODE == 2) { mreg0 = *(const GAS u64*)(bmrow + 2 * (jj)); mreg1 = *(const GAS u64*)(bmrow + 2 * (jj) + 1); } } while (0)
#define FL_STORET(bb, vbb) do { *(u32x4*)(lds + LDS_KS + (bb) * KS_BYTES + krow * ROWB + kch * 16) = kreg[0]; *(u32x4*)(lds + LDS_KS + (bb) * KS_BYTES + (64 + krow) * ROWB + kch * 16) = kreg[1]; \
        _Pragma("unroll") for (int i_ = 0; i_ < DV / 32; ++i_) { unsigned char* vd_ = lds + LDS_VS + (vbb) * VS_BYTES + (vrow + 32 * i_) * VROWB + vch * 16; \
            *(u32x2*)vd_ = (u32x2){vreg[i_][0], vreg[i_][1]}; *(u32x2*)(vd_ + 8) = (u32x2){vreg[i_][2], vreg[i_][3]}; } } while (0)
#define FL_NEXT(jj, out) do { out = (jj) + 1; if (MODE == 1) { while (out < ntile && !((umask >> (out >> 1)) & 1u)) out = (out | 1) + 1; } } while (0)
    __syncthreads();
    u64 mc0 = 0, mc1 = 0; int jn = ntile, cur = 0, vb = 0;
    const bool grpB = (DV == 64) && (wave >= 4);
    u32x4 pprev[8]; int vprev = -1;
#pragma unroll
    for (int e = 0; e < 8; ++e) pprev[e] = (u32x4){0u, 0u, 0u, 0u};
#define FL_VLOAD(DST, G) do { _Pragma("unroll") for (int dt_ = 0; dt_ < DV / 32; ++dt_) { \
        const unsigned char* vp_ = VS_ + (32 * dt_ + ql) * VROWB + (16 * (G) + 4 * h) * 2; \
        (DST)[2 * dt_] = *(const s16x4*)vp_; (DST)[2 * dt_ + 1] = *(const s16x4*)(vp_ + 16); } } while (0)
#define FL_PV(PW, VBUF) do { const unsigned char* VS_ = lds + LDS_VS + (VBUF) * VS_BYTES; \
        s16x4 fa_[2 * (DV / 32)], fb_[2 * (DV / 32)]; \
        FL_VLOAD(fa_, 0); \
        _Pragma("unroll") for (int g_ = 0; g_ < 8; g_ += 2) { \
            FL_VLOAD(fb_, g_ + 1); \
            { const bf16x8 pb_ = __builtin_bit_cast(bf16x8, (PW)[g_]); \
              _Pragma("unroll") for (int dt_ = 0; dt_ < DV / 32; ++dt_) o[dt_] = MFMA32(__builtin_shufflevector(fa_[2 * dt_], fa_[2 * dt_ + 1], 0, 1, 2, 3, 4, 5, 6, 7), pb_, o[dt_]); } \
            if (g_ + 2 < 8) FL_VLOAD(fa_, g_ + 2); \
            { const bf16x8 pb_ = __builtin_bit_cast(bf16x8, (PW)[g_ + 1]); \
              _Pragma("unroll") for (int dt_ = 0; dt_ < DV / 32; ++dt_) o[dt_] = MFMA32(__builtin_shufflevector(fb_[2 * dt_], fb_[2 * dt_ + 1], 0, 1, 2, 3, 4, 5, 6, 7), pb_, o[dt_]); } \
        } } while (0)
    if (j < ntile) {
        FL_LOADT(j); FL_STORET(0, 0); mc0 = mreg0; mc1 = mreg1;
        FL_NEXT(j, jn);
        if (jn < ntile) FL_LOADT(jn);
    }
    __syncthreads();
    while (j < ntile) {
        if (grpB && vprev >= 0) { FL_PV(pprev, vprev); vprev = -1; }
        const bool selq = (MODE == 1) ? (((qmask >> (j >> 1)) & 1u) != 0u) : true;
        u64 selb = ~0ull;
        if (MODE == 1) selb = __ballot(selq);
        const int k0 = j * 128;
        if ((k0 <= qw0 + 31) && (selb != 0ull)) {
            const unsigned char* KS = lds + LDS_KS + cur * KS_BYTES;
            f32x16 st[4];
#pragma unroll
            for (int t = 0; t < 4; ++t)
#pragma unroll
                for (int i = 0; i < 16; ++i) st[t][i] = 0.f;
#pragma unroll
            for (int t = 0; t < 4; ++t)
#pragma unroll
                for (int ks = 0; ks < 4; ++ks) {
                    const bf16x8 ka = *(const bf16x8*)(KS + (32 * t + ql) * ROWB + (16 * ks + 8 * h) * 2);
                    st[t] = MFMA32(ka, qf[ks], st[t]);
                }
            if (MODE == 2) {
#pragma unroll
                for (int t = 0; t < 4; ++t) {
                    const u64 mcur = (t >> 1) ? mc1 : mc0;
                    const unsigned wsel = (unsigned)((t & 1) ? (mcur >> 32) : mcur) >> (4 * h);
#pragma unroll
                    for (int i = 0; i < 16; ++i) { const int kr = (i & 3) + 8 * (i >> 2); st[t][i] = (((wsel >> kr) & 1u) != 0u) ? st[t][i] : NEG_INF; }
                }
            } else {
                const bool need_mask = (k0 + 127 > qw0) || (MODE == 1 && selb != ~0ull);
                if (need_mask) {
                    const int dq = q - k0 - 4 * h;
#pragma unroll
                    for (int t = 0; t < 4; ++t)
#pragma unroll
                        for (int i = 0; i < 16; ++i) { const int kr = (i & 3) + 8 * (i >> 2) + 32 * t; st[t][i] = (selq && (kr <= dq)) ? st[t][i] : NEG_INF; }
                }
            }
            float mx = fmaxf(st[0][0], st[1][0]);
#pragma unroll
            for (int i = 0; i < 16; ++i) mx = fmaxf(fmaxf(mx, st[0][i]), fmaxf(st[1][i], fmaxf(st[2][i], st[3][i])));
            mx = fmaxf(mx, shx(mx, 32, lane)) * SM_C;
            const float m_new = fmaxf(m_run, mx), m_use = (m_new == NEG_INF) ? 0.f : m_new;
            const float alpha = __builtin_amdgcn_exp2f(m_run - m_use);
            const f32x2_t c2 = {SM_C, SM_C}, nm2 = {-m_use, -m_use};
            f32x2_t ps2 = {0.f, 0.f};
#pragma unroll
            for (int t = 0; t < 4; ++t)
#pragma unroll
                for (int i = 0; i < 16; i += 2) {
                    f32x2_t a2 = {st[t][i], st[t][i + 1]};
                    a2 = a2 * c2 + nm2;
                    f32x2_t e2; e2[0] = __builtin_amdgcn_exp2f(a2[0]); e2[1] = __builtin_amdgcn_exp2f(a2[1]);
                    st[t][i] = e2[0]; st[t][i + 1] = e2[1]; ps2 = ps2 + e2;
                }
            l_run = l_run * alpha + (ps2[0] + ps2[1]);
            if (__ballot(m_new > m_run) != 0ull) {
#pragma unroll
                for (int dt = 0; dt < DV / 32; ++dt) o[dt] = o[dt] * alpha;
            }
            m_run = m_new;
#pragma unroll
            for (int t = 0; t < 4; ++t)
#pragma unroll
                for (int s2 = 0; s2 < 2; ++s2) {
                    pprev[2 * t + s2][0] = pk2(st[t][8 * s2], st[t][8 * s2 + 1]); pprev[2 * t + s2][1] = pk2(st[t][8 * s2 + 2], st[t][8 * s2 + 3]);
                    pprev[2 * t + s2][2] = pk2(st[t][8 * s2 + 4], st[t][8 * s2 + 5]); pprev[2 * t + s2][3] = pk2(st[t][8 * s2 + 6], st[t][8 * s2 + 7]);
                }
            if (!grpB) { FL_PV(pprev, vb); } else vprev = vb;
        }
        int jnn = ntile; u64 mn0 = 0, mn1 = 0;
        const int vbn = (vb == 2) ? 0 : vb + 1;
        if (jn < ntile) { FL_STORET(cur ^ 1, vbn); mn0 = mreg0; mn1 = mreg1; FL_NEXT(jn, jnn); if (jnn < ntile) FL_LOADT(jnn); }
        asm volatile("s_waitcnt lgkmcnt(0)\n\ts_barrier" ::: "memory");
        j = jn; jn = jnn; cur ^= 1; vb = vbn; mc0 = mn0; mc1 = mn1;
    }
    if (grpB && vprev >= 0) { FL_PV(pprev, vprev); }
#undef FL_PV
#undef FL_VLOAD
#undef FL_LOADT
#undef FL_STORET
#undef FL_NEXT
}

DI u32x4 widen_pair(u32x2 a  , u32x2 b  ) {
    const auto r0 = __builtin_amdgcn_permlane32_swap(a[0], b[0], false, false);
    const auto r1 = __builtin_amdgcn_permlane32_swap(a[1], b[1], false, false);
    return (u32x4){r0[0], r1[0], r0[1], r1[1]};
}
DI void write_o64(const f32x16 (&o)[2], float l_run, bf16_t* mixrow  , int wave, int lane) {
    const int h = lane >> 5, ql = lane & 31;
    const float inv = 1.f / (l_run + shx(l_run, 32, lane));
    bf16_t* rp = mixrow + (size_t)(32 * wave + ql) * DM;
#pragma unroll
    for (int dt = 0; dt < 2; ++dt)
#pragma unroll
        for (int pr = 0; pr < 2; ++pr) {
            u32x2 a, b2;
            a[0] = pk2(o[dt][8 * pr] * inv, o[dt][8 * pr + 1] * inv); a[1] = pk2(o[dt][8 * pr + 2] * inv, o[dt][8 * pr + 3] * inv);
            b2[0] = pk2(o[dt][8 * pr + 4] * inv, o[dt][8 * pr + 5] * inv); b2[1] = pk2(o[dt][8 * pr + 6] * inv, o[dt][8 * pr + 7] * inv);
            *(GAS u32x4*)(rp + 32 * dt + 16 * pr + 8 * h) = widen_pair(a, b2);
        }
}

DI void moba_unit(const Params& p, unsigned char* lds, int l, int b, int hh, int cur) {
    const int tid = opaque_tid(), lane = tid & 63, wave = __builtin_amdgcn_readfirstlane(tid >> 6);
    const bf16_t* QK = gp((const bf16_t*)(p.ws + WS_QK));
    const bf16_t* Qp = QK + ((size_t)(0 + hh) * MTOK + (size_t)b * SEQ) * 64;
    const bf16_t* Kp = QK + ((size_t)(4 + hh) * MTOK + (size_t)b * SEQ) * 64;
    const bf16_t* VTp = gp((const bf16_t*)(p.ws + WS_VT)) + (size_t)(64 * hh) * MTOK + (size_t)b * SEQ;
    const float* kmean = gp((const float*)(p.ws + WS_KMEAN)) + (size_t)l * 32768;
    volatile unsigned* QM = (volatile unsigned*)(lds + LDS_QM); unsigned* MISC = (unsigned*)(lds + LDS_MISC);
    const int q0 = cur * 256;
    float* kml = (float*)(lds + LDS_KS);
    for (int e = tid; e < cur * 64; e += 512) kml[e] = kmean[((size_t)(b * 16 + (e >> 6)) * 4 + hh) * 64 + (e & 63)];
    __syncthreads();
    if (tid < 256) {
        const u32x4* qr = (const u32x4*)(Qp + (size_t)(q0 + tid) * 64);
        float qv[64];
#pragma unroll
        for (int c = 0; c < 8; ++c) { const u32x4 w = qr[c];
#pragma unroll
            for (int e = 0; e < 4; ++e) { qv[8 * c + 2 * e] = bf_lo(w[e]); qv[8 * c + 2 * e + 1] = bf_hi(w[e]); } }
        float b0 = NEG_INF, b1 = NEG_INF, b2 = NEG_INF; int i0 = -1, i1 = -1, i2 = -1;
        for (int n = 0; n < cur; ++n) {
            const f32x4* km = (const f32x4*)(kml + n * 64);
            float g = 0.f;
#pragma unroll
            for (int d4 = 0; d4 < 16; ++d4) { const f32x4 k4 = km[d4]; g = fmaf(qv[4 * d4], k4[0], g); g = fmaf(qv[4 * d4 + 1], k4[1], g); g = fmaf(qv[4 * d4 + 2], k4[2], g); g = fmaf(qv[4 * d4 + 3], k4[3], g); }
            if (g > b0) { b2 = b1; i2 = i1; b1 = b0; i1 = i0; b0 = g; i0 = n; }
            else if (g > b1) { b2 = b1; i2 = i1; b1 = g; i1 = n; }
            else if (g > b2) { b2 = g; i2 = n; }
        }
        unsigned mask = 1u << cur;
        if (i0 >= 0) mask |= 1u << i0; if (i1 >= 0) mask |= 1u << i1; if (i2 >= 0) mask |= 1u << i2;
        QM[tid] = mask; atomicOr(&MISC[1], mask);
    }
    __syncthreads();
    const unsigned umask = MISC[1], qmask = QM[32 * wave + (lane & 31)];
    f32x16 o[2]; float m_run, l_run;
    flash_pass<64, 1>(lds, Qp, Kp, VTp, q0, o, m_run, l_run, qmask, umask, nullptr);
    write_o64(o, l_run, gp((bf16_t*)p.out + (size_t)MTOK * DM) + ((size_t)b * SEQ + q0) * DM + 64 * hh, wave, lane);
}

DI void dsa_unit(const Params& p, unsigned char* lds, int b, int hh, int cur) {
    const int tid = opaque_tid(), lane = tid & 63, wave = __builtin_amdgcn_readfirstlane(tid >> 6);
    const bf16_t* QK = gp((const bf16_t*)(p.ws + WS_QK));
    const bf16_t* Qp = QK + ((size_t)(24 + hh) * MTOK + (size_t)b * SEQ) * 64;
    const bf16_t* Kp = QK + ((size_t)(28 + hh) * MTOK + (size_t)b * SEQ) * 64;
    const bf16_t* VTp = gp((const bf16_t*)(p.ws + WS_VT)) + (size_t)(768 + 64 * hh) * MTOK + (size_t)b * SEQ;
    const int q0 = cur * 256;
    const u64* bmrow = gp((const u64*)(p.ws + WS_BM)) + ((size_t)b * SEQ + q0 + 32 * wave + (lane & 31)) * 64;
    f32x16 o[2]; float m_run, l_run;
    flash_pass<64, 2>(lds, Qp, Kp, VTp, q0, o, m_run, l_run, 0u, 0u, bmrow);
    write_o64(o, l_run, gp((bf16_t*)p.out + (size_t)MTOK * DM) + ((size_t)b * SEQ + q0) * DM + 768 + 64 * hh, wave, lane);
}

DI void diff_unit(const Params& p, unsigned char* lds, int l, int b, int hh, int cur) {
    const int tid = opaque_tid(), lane = tid & 63, wave = __builtin_amdgcn_readfirstlane(tid >> 6), h = lane >> 5, ql = lane & 31;
    const bf16_t* QK = gp((const bf16_t*)(p.ws + WS_QK));
    const bf16_t* VTp = gp((const bf16_t*)(p.ws + WS_VT)) + (size_t)(256 + 128 * hh) * MTOK + (size_t)b * SEQ;
    const int q0 = cur * 256;
    f32x16 o1[4]; float m1, l1;
    float* sto = gp((float*)(p.ws + WS_SCR)) + (size_t)blockIdx.x * (32 * SEQ) + (size_t)(32 * wave + ql) * 128;
    flash_pass<128, 0>(lds, QK + ((size_t)(8 + 2 * hh) * MTOK + (size_t)b * SEQ) * 64, QK + ((size_t)(16 + 2 * hh) * MTOK + (size_t)b * SEQ) * 64, VTp, q0, o1, m1, l1, 0u, 0u, nullptr);
    {
        const float r1 = 1.f / (l1 + shx(l1, 32, lane));
#pragma unroll
        for (int dt = 0; dt < 4; ++dt)
#pragma unroll
            for (int g = 0; g < 4; ++g) { f32x4 v = {o1[dt][4 * g] * r1, o1[dt][4 * g + 1] * r1, o1[dt][4 * g + 2] * r1, o1[dt][4 * g + 3] * r1}; *(f32x4*)(sto + 32 * dt + 8 * g + 4 * h) = v; }
    }
    flash_pass<128, 0>(lds, QK + ((size_t)(9 + 2 * hh) * MTOK + (size_t)b * SEQ) * 64, QK + ((size_t)(17 + 2 * hh) * MTOK + (size_t)b * SEQ) * 64, VTp, q0, o1, m1, l1, 0u, 0u, nullptr);
    const float* lp = p.dlam + l * 256;
    float d1 = 0.f, d2 = 0.f;
    for (int d = 0; d < 64; ++d) { d1 = fmaf(lp[d], lp[64 + d], d1); d2 = fmaf(lp[128 + d], lp[192 + d], d2); }
    const float lam_init = (l == 0) ? 0.2f : (0.8f - 0.6f * 0.7408182206817179f);
    const float lam = expf(d1) - expf(d2) + lam_init;
    const float r2 = lam / (l1 + shx(l1, 32, lane));
    float ss = 0.f;
#pragma unroll
    for (int dt = 0; dt < 4; ++dt)
#pragma unroll
        for (int g = 0; g < 4; ++g) {
            const f32x4 a = *(const f32x4*)(sto + 32 * dt + 8 * g + 4 * h);
#pragma unroll
            for (int e = 0; e < 4; ++e) { const float v = a[e] - o1[dt][4 * g + e] * r2; o1[dt][4 * g + e] = v; ss = fmaf(v, v, ss); }
        }
    ss += shx(ss, 32, lane);
    const float rn = rsqrtf(ss * (1.f / 128.f) + EPS) * (1.f - lam_init);
    const float* sg = p.subln + l * 128;
    bf16_t* rp = gp((bf16_t*)p.out + (size_t)MTOK * DM) + ((size_t)b * SEQ + q0 + 32 * wave + ql) * DM + 256 + 128 * hh;
#pragma unroll
    for (int dt = 0; dt < 4; ++dt)
#pragma unroll
        for (int pr = 0; pr < 2; ++pr) {
            u32x2 ab[2];
#pragma unroll
            for (int e = 0; e < 2; ++e) {
                const int g = 2 * pr + e, d0 = 32 * dt + 8 * g + 4 * h;
                const f32x4 gv = *(const f32x4*)(sg + d0);
                ab[e][0] = pk2(o1[dt][4 * g] * rn * gv[0], o1[dt][4 * g + 1] * rn * gv[1]); ab[e][1] = pk2(o1[dt][4 * g + 2] * rn * gv[2], o1[dt][4 * g + 3] * rn * gv[3]);
            }
            *(GAS u32x4*)(rp + 32 * dt + 16 * pr + 8 * h) = widen_pair(ab[0], ab[1]);
        }
}

DI unsigned ord_key(float v) { v += 0.f; const unsigned b = __builtin_bit_cast(unsigned, v); return b ^ ((b & 0x80000000u) ? 0xffffffffu : 0x80000000u); }
constexpr int LDS_SEL = 61440, SEL_STRIDE = 6144;
DI float key_f(unsigned u) { const unsigned b = (u & 0x80000000u) ? (u ^ 0x80000000u) : ~u; return __builtin_bit_cast(float, b); }
DI void select_unit(const Params& p, unsigned char* lds, int b, int q0) {
    const int tid = opaque_tid(), lane = tid & 63, wave = __builtin_amdgcn_readfirstlane(tid >> 6);
    float* scr = gp((float*)(p.ws + WS_SCR)) + (size_t)blockIdx.x * (32 * SEQ);
    u64* bm = gp((u64*)(p.ws + WS_BM));
    if (q0 >= 256) {
        const bf16_t* QK = gp((const bf16_t*)(p.ws + WS_QK));
        const bf16_t* IK = QK + ((size_t)40 * MTOK + (size_t)b * SEQ) * 64;
        const int qi = lane & 15, kq = lane >> 4, qrow = 16 * (wave >> 2) + qi, kw = wave & 3;
        const float* iwp = gp((const float*)(p.ws + WS_IW)) + ((size_t)b * SEQ + q0 + qrow) * 8;
        bf16x8 qf[8][2]; float w[8];
        const f32x4 wa = *(const f32x4*)iwp, wb = *(const f32x4*)(iwp + 4);
#pragma unroll
        for (int e = 0; e < 4; ++e) { w[e] = wa[e]; w[4 + e] = wb[e]; }
#pragma unroll
        for (int hh = 0; hh < 8; ++hh)
#pragma unroll
            for (int ks = 0; ks < 2; ++ks) qf[hh][ks] = *(const bf16x8*)(QK + ((size_t)(32 + hh) * MTOK + (size_t)b * SEQ + q0 + qrow) * 64 + 32 * ks + 8 * kq);
        const int n32 = (q0 + 32) >> 5;
        const bf16_t* kbase = IK + (size_t)qi * 64 + 8 * kq;
        for (int srep = 0; srep < SEL_REP_SCORE; ++srep) {
        bf16x8 kf[2][2];
        if (kw < n32) {
#pragma unroll
            for (int sub = 0; sub < 2; ++sub)
#pragma unroll
                for (int ks = 0; ks < 2; ++ks) kf[sub][ks] = *(const GAS bf16x8*)(kbase + (size_t)(32 * kw + 16 * sub) * 64 + 32 * ks);
        }
#pragma unroll 1
        for (int t = kw; t < n32; t += 4) {
            const int k0 = 32 * t;
            bf16x8 kn[2][2];
            const int tn = (t + 4 < n32) ? t + 4 : t;
#pragma unroll
            for (int sub = 0; sub < 2; ++sub)
#pragma unroll
                for (int ks = 0; ks < 2; ++ks) kn[sub][ks] = *(const GAS bf16x8*)(kbase + (size_t)(32 * tn + 16 * sub) * 64 + 32 * ks);
            f32x4 sc[2];
#pragma unroll
            for (int sub = 0; sub < 2; ++sub) sc[sub] = (f32x4){0.f, 0.f, 0.f, 0.f};
#pragma unroll
            for (int hh = 0; hh < 8; ++hh)
#pragma unroll
                for (int sub = 0; sub < 2; ++sub) {
                    f32x4 a = {0.f, 0.f, 0.f, 0.f};
                    a = __builtin_amdgcn_mfma_f32_16x16x32_bf16(kf[sub][0], qf[hh][0], a, 0, 0, 0);
                    a = __builtin_amdgcn_mfma_f32_16x16x32_bf16(kf[sub][1], qf[hh][1], a, 0, 0, 0);
#pragma unroll
                    for (int i = 0; i < 4; ++i) sc[sub][i] = fmaf(w[hh], fmaxf(a[i], 0.f), sc[sub][i]);
                    if (sub == 1 && (hh & 3) == 3) __builtin_amdgcn_sched_barrier(0);
                }
#pragma unroll
            for (int sub = 0; sub < 2; ++sub) *(GAS f32x4*)(scr + (size_t)qrow * SEQ + k0 + 16 * sub + 4 * kq) = sc[sub];
#pragma unroll
            for (int sub = 0; sub < 2; ++sub)
#pragma unroll
                for (int ks = 0; ks < 2; ++ks) kf[sub][ks] = kn[sub][ks];
        }
        }
        __syncthreads();
    }
    LAS unsigned* hist = (LAS unsigned*)((LAS unsigned char*)lds + LDS_SEL + wave * SEL_STRIDE + 16);
    LAS float* listv = (LAS float*)(hist + 1024);
    LAS int* listi = (LAS int*)(hist + 1088);
    LAS unsigned* misc = hist + 1152;
#define SEL_CB() asm volatile("" ::: "memory")
#define SEL_WAIT() asm volatile("s_waitcnt lgkmcnt(0)" ::: "memory")
#pragma unroll 1
    for (int rr0 = 0; rr0 < 4 * SEL_REP_ROWS; ++rr0) {
        const int rr = rr0 & 3;
        const int r = wave * 4 + rr, qpos = q0 + r;
        int ln = lane; asm volatile("" : "+v"(ln));
        u64* bmr = bm + ((size_t)b * SEQ + qpos) * 64;
        if (qpos < 256) {
            const int rem = qpos - ln * 64;
            bmr[ln] = (rem >= 63) ? ~0ull : (rem < 0) ? 0ull : ((2ull << rem) - 1ull);
            continue;
        }
        const int ng = (qpos >> 9) + 1;
        float v[64];
        const float* sr = scr + (size_t)r * SEQ;
#pragma unroll
        for (int g8 = 0; g8 < 8; ++g8) {
#pragma unroll
            for (int jj = 0; jj < 8; ++jj) v[8 * g8 + jj] = NEG_INF;
            if (g8 < ng) {
#pragma unroll
                for (int jj = 0; jj < 8; ++jj) { const int j = 8 * g8 + jj; const float t = *(const GAS float*)(sr + 64 * j + ln); v[j] = (ln <= qpos - 64 * j) ? (t + 0.f) : NEG_INF; }
            }
        }
        float lmax = NEG_INF, lmin = -NEG_INF;
#pragma unroll
        for (int g8 = 0; g8 < 8; ++g8) {
            if (g8 < ng) {
#pragma unroll
                for (int jj = 0; jj < 8; ++jj) { const int j = 8 * g8 + jj; lmax = fmaxf(lmax, v[j]); lmin = fminf(lmin, (v[j] == NEG_INF) ? -NEG_INF : v[j]); }
            }
        }
        SEL_WAIT();
        if (ln == 0) { misc[0] = 0u; misc[1] = 0xffffffffu; misc[2] = 0u; }
        {
            LAS u32x4* hz = (LAS u32x4*)(hist + 16 * ln);
            const u32x4 z = {0u, 0u, 0u, 0u};
            hz[0] = z; hz[1] = z; hz[2] = z; hz[3] = z;
        }
        SEL_CB();
        atomicMax((unsigned*)&misc[0], ord_key(lmax)); atomicMin((unsigned*)&misc[1], ord_key(lmin));
        SEL_WAIT();
        const float hi = key_f(misc[0]), lo = key_f(misc[1]);
        const float inv = 1024.f / (hi - lo), c0 = -lo * inv;
        bool fast = (hi > lo) && (inv < 1e37f);
        float Tv = 0.f; int Ti = 0;
        if (fast) {
            unsigned pb[32];
#pragma unroll
            for (int e = 0; e < 32; ++e) pb[e] = 0u;
#pragma unroll
            for (int g8 = 0; g8 < 8; ++g8) {
                if (g8 < ng) {
#pragma unroll
                    for (int jj = 0; jj < 8; ++jj) { const int j = 8 * g8 + jj;
                        int bin = (int)fmaf(v[j], inv, c0); bin = bin < -1 ? -1 : (bin > 1023 ? 1023 : bin);
                        atomicAdd((unsigned*)(hist + bin), 1u);
                        for (int xa = 0; xa < PROBE_XATOM; ++xa) atomicAdd((unsigned*)(hist + bin), 0u);
                        pb[j >> 1] |= (unsigned)(bin + 1) << (16 * (j & 1)); }
                }
            }
            SEL_WAIT();
            unsigned c[16]; unsigned tot = 0;
            {
                LAS u32x4* hz = (LAS u32x4*)(hist + 16 * ln);
#pragma unroll
                for (int e = 0; e < 4; ++e) { const u32x4 t4 = hz[e]; c[4 * e] = t4[0]; c[4 * e + 1] = t4[1]; c[4 * e + 2] = t4[2]; c[4 * e + 3] = t4[3]; tot += t4[0] + t4[1] + t4[2] + t4[3]; }
            }
            unsigned suf = tot;
#pragma unroll
            for (int d = 1; d < 64; d <<= 1) { const unsigned o = (unsigned)__builtin_amdgcn_ds_bpermute(((ln + d) & 63) << 2, (int)suf); suf += (ln + d < 64) ? o : 0u; }
            const u64 ge = __ballot(suf >= 256u);
            const int Ls = 63 - __builtin_clzll(ge);
            unsigned cum = suf - tot; int bsel = 0; unsigned above = 0, cstar = 0; bool found = false;
#pragma unroll
            for (int t = 15; t >= 0; --t) { if (!found && cum + c[t] >= 256u) { found = true; bsel = 16 * ln + t; above = cum; cstar = c[t]; } cum += c[t]; }
            const int bstar = __builtin_amdgcn_readlane(bsel, Ls); const int need = 256 - __builtin_amdgcn_readlane((int)above, Ls); const int ncand = __builtin_amdgcn_readlane((int)cstar, Ls);
            if (ncand > 64) fast = false;
            else {
                SEL_CB();
                const unsigned blo = (unsigned)(bstar + 1), bhi = blo << 16;
#pragma unroll
                for (int g8 = 0; g8 < 8; ++g8) {
                    if (g8 < ng) {
#pragma unroll
                        for (int jj = 0; jj < 8; ++jj) { const int j = 8 * g8 + jj;
                            const bool is = (j & 1) ? ((pb[j >> 1] & 0xffff0000u) == bhi) : ((pb[j >> 1] & 0xffffu) == blo);
                            if (is) { const unsigned pos = atomicAdd((unsigned*)&misc[2], 1u); listv[pos & 63] = v[j]; listi[pos & 63] = 64 * j + ln; } }
                    }
                }
                SEL_WAIT();
                const float mv = listv[ln]; const int mi = listi[ln];
                int rank = 0;
                for (int i = 0; i < ncand; ++i) { const float ov = listv[i]; const int oi = listi[i]; rank += ((ov > mv) || (ov == mv && oi < mi)) ? 1 : 0; }
                const u64 hit = __ballot(ln < ncand && rank == need - 1);
                const int Lt = __builtin_ctzll(hit);
                Tv = __builtin_bit_cast(float, __builtin_amdgcn_readlane(__builtin_bit_cast(int, mv), Lt)); Ti = __builtin_amdgcn_readlane(mi, Lt);
            }
        }
        if (!fast) {
            unsigned T = 0u;
#pragma unroll 1
            for (int bit = 31; bit >= 0; --bit) {
                const unsigned cand = T | (1u << bit);
                int cc = 0;
#pragma unroll
                for (int j = 0; j < 64; ++j) cc += (v[j] != NEG_INF && ord_key(v[j]) >= cand) ? 1 : 0;
                int totc = 0;
#pragma unroll
                for (int bb = 0; bb < 7; ++bb) totc += __builtin_popcountll(__ballot((cc >> bb) & 1)) << bb;
                if (totc >= 256) T = cand;
            }
            Tv = key_f(T);
            int cc = 0;
#pragma unroll
            for (int j = 0; j < 64; ++j) cc += (v[j] > Tv) ? 1 : 0;
            int cgt = 0;
#pragma unroll
            for (int bb = 0; bb < 7; ++bb) cgt += __builtin_popcountll(__ballot((cc >> bb) & 1)) << bb;
            const int need = 256 - cgt;
            int taken = 0; Ti = -1;
#pragma unroll
            for (int j = 0; j < 64; ++j) {
                const u64 eq = __ballot(v[j] == Tv);
                const int ce = __builtin_popcountll(eq);
                if (Ti < 0 && taken + ce >= need) {
                    int k = need - taken; u64 e = eq; int lanepos = 0;
                    while (k > 0) { lanepos = __builtin_ctzll(e); e &= e - 1; --k; }
                    Ti = 64 * j + lanepos;
                }
                taken += ce;
            }
        }
        unsigned wlo = 0u, whi = 0u;
#pragma unroll
        for (int g8 = 0; g8 < 8; ++g8) {
            if (g8 < ng) {
#pragma unroll
                for (int jj = 0; jj < 8; ++jj) { const int j = 8 * g8 + jj;
                    const u64 word = __ballot((v[j] > Tv) || (v[j] == Tv && ln <= Ti - 64 * j));
                    if (ln == j) { wlo = (unsigned)word; whi = (unsigned)(word >> 32); } }
            }
        }
        *(GAS u64*)(bmr + ln) = (u64)wlo | ((u64)whi << 32);
    }
#undef SEL_CB
#undef SEL_WAIT
}

DI void kmean_unit(const Params& p, unsigned char* lds, int l, int b, int hh, int blk) {
    const int tid = opaque_tid(), lane = tid & 63, wave = __builtin_amdgcn_readfirstlane(tid >> 6), ch = tid & 7, rg = tid >> 3;
    const bf16_t* Kp = gp((const bf16_t*)(p.ws + WS_QK)) + ((size_t)(4 + hh) * MTOK + (size_t)b * SEQ + blk * 256) * 64;
    float a[8];
#pragma unroll
    for (int e = 0; e < 8; ++e) a[e] = 0.f;
#pragma unroll
    for (int i = 0; i < 4; ++i) { const u32x4 w = *(const u32x4*)(Kp + (size_t)(rg + 64 * i) * 64 + ch * 8);
#pragma unroll
        for (int e = 0; e < 4; ++e) { a[2 * e] += bf_lo(w[e]); a[2 * e + 1] += bf_hi(w[e]); } }
#pragma unroll
    for (int e = 0; e < 8; ++e) { float v = a[e]; v += shx(v, 8, lane); v += shx(v, 16, lane); v += shx(v, 32, lane); a[e] = v; }
    float* red = (float*)(lds + LDS_KS);
    if (lane < 8) {
#pragma unroll
        for (int e = 0; e < 8; ++e) red[wave * 64 + lane * 8 + e] = a[e];
    }
    __syncthreads();
    if (tid < 64) { float sacc = 0.f;
#pragma unroll
        for (int w = 0; w < 8; ++w) sacc += red[w * 64 + tid];
        (gp((float*)(p.ws + WS_KMEAN)))[(size_t)l * 32768 + ((size_t)(b * 16 + blk) * 4 + hh) * 64 + tid] = sacc * (1.f / 256.f); }
}

#define XB_TMO      128
#define XB_XCNT(j)  (256  + 64 * (j))
#define XB_XSUB(j)  (1280 + 64 * (j))
#define XB_XGEN(j)  (2304 + 64 * (j))
#define XB_TOP      3328
#define XB_TOPGEN   3392
#define XCD_BAR_WORDS 3456
#define XB_SPIN_CAP (1u << 18)

__device__ __forceinline__ unsigned xb_ld(unsigned* p)              { return __hip_atomic_load(p, __ATOMIC_RELAXED, __HIP_MEMORY_SCOPE_AGENT); }
__device__ __forceinline__ unsigned xb_add(unsigned* p, unsigned v) { return __hip_atomic_fetch_add(p, v, __ATOMIC_RELAXED, __HIP_MEMORY_SCOPE_AGENT); }
__device__ __forceinline__ unsigned xb_xcc_id() { return (unsigned)__builtin_amdgcn_s_getreg((3 << 11) | 20) & 0xFu; }
#define XB_SPIN(cond, bar) do { unsigned _sp = 0; while (cond) { __builtin_amdgcn_s_sleep(1); \
    if ((++_sp & 255u) == 0u) { if (xb_ld(&(bar)[XB_TMO])) break; if (_sp > XB_SPIN_CAP) { atomicAdd(&(bar)[XB_TMO], 1u); break; } } } } while (0)

struct XcdBarrier {
    unsigned* bar; unsigned x;
    volatile LAS unsigned* st;
};

__device__ __forceinline__ XcdBarrier xcd_barrier_post(unsigned* bar, volatile LAS unsigned* st) {
    XcdBarrier b; b.bar = bar; b.x = xb_xcc_id(); b.st = st;
    if (threadIdx.x == 0) (void)xb_add(&bar[XB_XCNT(b.x)], 1u);
    return b;
}
__device__ __forceinline__ void xcd_barrier_complete(unsigned* bar, unsigned x, unsigned& nloc, unsigned& nx) {
    const unsigned G = gridDim.x * gridDim.y * gridDim.z;
    unsigned sum, cnt, mine, sp = 0u;
    for (;;) {
        sum = 0u; cnt = 0u; mine = 0u;
#pragma unroll
        for (unsigned j = 0; j < 16; ++j) { const unsigned c = xb_ld(&bar[XB_XCNT(j)]); sum += c; cnt += (c > 0u) ? 1u : 0u; mine = (j == x) ? c : mine; }
        if (sum == G) break;
        __builtin_amdgcn_s_sleep(1);
        if ((++sp & 255u) == 0u) { if (xb_ld(&bar[XB_TMO])) break; if (sp > XB_SPIN_CAP) { atomicAdd(&bar[XB_TMO], 1u); break; } }
    }
    nloc = mine > 0u ? mine : 1u; nx = cnt > 0u ? cnt : 1u;
}

__device__ __forceinline__ void xcd_barrier(const XcdBarrier& b) {
    asm volatile("s_waitcnt vmcnt(0)" ::: "memory");
    __syncthreads();
    if (threadIdx.x == 0) {
        unsigned* bar = b.bar;
        __builtin_amdgcn_s_waitcnt(0);
        unsigned nloc = b.st[0], nx = b.st[1];
        if (nloc == 0u) { xcd_barrier_complete(bar, b.x, nloc, nx); b.st[0] = nloc; b.st[1] = nx; }
        const unsigned old = xb_add(&bar[XB_XSUB(b.x)], 1u);
        const unsigned gen = old / nloc;
        if (old + 1u == (gen + 1u) * nloc) {
            __builtin_amdgcn_fence(__ATOMIC_RELEASE, "agent");
            asm volatile("s_waitcnt vmcnt(0)" ::: "memory");
            const unsigned og = xb_add(&bar[XB_TOP], 1u);
            const unsigned tg = og / nx;
            if (og + 1u == (tg + 1u) * nx) xb_add(&bar[XB_TOPGEN], 1u);
            else XB_SPIN(xb_ld(&bar[XB_TOPGEN]) == tg, bar);
            __builtin_amdgcn_fence(__ATOMIC_ACQUIRE, "agent");
            xb_add(&bar[XB_XGEN(b.x)], 1u);
            asm volatile("s_waitcnt vmcnt(0)" ::: "memory");
        } else {
            XB_SPIN(xb_ld(&bar[XB_XGEN(b.x)]) == gen, bar);
            __builtin_amdgcn_fence(__ATOMIC_ACQUIRE, "agent");
            asm volatile("s_waitcnt vmcnt(0)" ::: "memory");
        }
    }
    __syncthreads();
}

DI int next_item(unsigned char* lds, unsigned* ctr) {
    unsigned* MISC = (unsigned*)(lds + LDS_MISC);
    __syncthreads();
    if (opaque_tid() == 0) { MISC[0] = atomicAdd(ctr, 1u); MISC[1] = 0u; }
    __syncthreads();
    return (int)MISC[0];
}

__global__ void __launch_bounds__(512, 2) mega_fwd(Params p) {
    extern __shared__ __attribute__((aligned(16))) unsigned char lds[];
    cg::grid_group grid = cg::this_grid();
    const int tid = opaque_tid(), lane = tid & 63, wave = __builtin_amdgcn_readfirstlane(tid >> 6);
    PG8_LAS unsigned char* lds3 = (PG8_LAS unsigned char*)lds;
    const Params& p0 = p;
    if (p0.ph_lo < 0) grid.sync();
    volatile LAS unsigned* bst = (volatile LAS unsigned*)(lds3 + LDS_BST);
    if (threadIdx.x == 0) { bst[0] = 0u; bst[1] = 0u; }
    __syncthreads();
    const XcdBarrier gbar = xcd_barrier_post((unsigned*)(p0.ws + WS_CTL) + CW_BAR, bst);
#define GSYNC() xcd_barrier(gbar)
    for (int xs = 0; xs < EXTRA_SYNCS; ++xs) GSYNC();
    for (int ph = p0.ph_lo; ph < p0.ph_hi; ++ph) {
        if ((ph & 7) == 5 || ph == 8) continue;
        if (ph > p0.ph_lo) GSYNC();
        Params p = p0;
        { unsigned char* w_ = p0.ws; asm volatile("" : "+s"(w_)); p.ws = (unsigned char*)(__attribute__((address_space(1))) unsigned char*)w_; }
        unsigned char* ws = p.ws;
        bf16_t* XB = (bf16_t*)(ws + WS_XB);
        unsigned* ctr = (unsigned*)(ws + WS_CTL);
        const int l = ph >> 3, k = ph & 7;
        const float* xin = (l == 0) ? p.x : p.out;
        const int nrep = ((REP_MASK >> k) & 1) ? 2 : 1;
        for (int rep = 0; rep < nrep; ++rep) {
        if (rep > 0) GSYNC();
        if (k == 0 && (PH_MASK & 1)) {
            if (l == 0) prologue_weights(p, lds);
            norm_rows(xin, XB, (float*)(ws + WS_RSS));
        } else if (k == 1 && (PH_MASK & 2)) {
#if !defined(SKIP_G1A)
            const bf16_t* XA = (l == 0) ? XB : (const bf16_t*)p.out;
            { pg8::Gemm g{XA, (const bf16_t*)(ws + WS_W1A) + (size_t)l * N1A * DM, MTOK, N1A, DM}; pg8::StaticOrder S; S.init(MTOK, N1A, gridDim.x, blockIdx.x);
              EpiQK E{(bf16_t*)(ws + WS_QK), (float*)(ws + WS_IW), (const float*)(ws + WS_CS), p.qg + l * 192, p.kg + l * 192, (const float*)(ws + WS_RSS) + (size_t)(2 * l) * MTOK};
              pg8::gemm_phase<EpiQK, pg8::StaticOrder, true, true>(lds3, g, S, E); }
#endif
#if !defined(SKIP_G1B)
            { pg8::Gemm g{(const bf16_t*)(ws + WS_W1B) + (size_t)l * DM * DM, XA, DM, MTOK, DM}; pg8::StaticOrder S; S.init(DM, MTOK, gridDim.x, blockIdx.x);
              EpiVT E{(bf16_t*)(ws + WS_VT), MTOK, (const float*)(ws + WS_RSS) + (size_t)(2 * l) * MTOK};
              pg8::gemm_phase<EpiVT, pg8::StaticOrder, true, true>(lds3, g, S, E); }
#endif
        } else if (k == 2 && (PH_MASK & 4)) {
            for (;;) {
                const int it = next_item(lds, ctr + 16 * (2 * l) + 64 * rep);
                if (it >= 512 + 1024 + 512) break;
                if (it < 512) {
#if !defined(SKIP_DIFF)
                    if (!(REP_SKIP_DIFF && rep > 0)) diff_unit(p, lds, l, (it & 31) >> 2, it & 3, 15 - (it >> 5));
#endif
                } else if (it < 1536) {
#if !defined(SKIP_SEL)
                    const int s = it - 512; select_unit(p, lds, s & 7, 32 * (127 - (s >> 3)));
#endif
                } else { const int s = it - 1536; kmean_unit(p, lds, l, s >> 6, (s >> 4) & 3, s & 15); }
            }
        } else if (k == 3 && (PH_MASK & 8)) {
            for (;;) {
                const int it = next_item(lds, ctr + 16 * (2 * l + 1) + 64 * rep);
                if (it >= 1024) break;
                const int c = 15 - (it >> 6), bh = it & 31;
                if (((it >> 5) & 1) == 0) dsa_unit(p, lds, bh >> 2, bh & 3, c); else moba_unit(p, lds, l, bh >> 2, bh & 3, c);
            }
        } else if (k == 4 && (PH_MASK & 16)) {
            pg8::Gemm g{(const bf16_t*)p.out + (size_t)MTOK * DM, (const bf16_t*)(ws + WS_WO) + (size_t)l * DM * DM, MTOK, DM, DM};     pg8::StaticOrder S; S.init(MTOK, DM, gridDim.x, blockIdx.x);
            EpiRes E{nullptr, (l == 0) ? (const bf16_t*)XB : (const bf16_t*)p.out, nullptr, (bf16_t*)(ws + WS_SCR), (float*)(ws + WS_RSS) + (size_t)(2 * l + 1) * MTOK};
            pg8::gemm_phase<EpiRes, pg8::StaticOrder, true, true>(lds3, g, S, E);
        } else if (k == 5 && (PH_MASK & 32)) {
        } else if (k == 6 && (PH_MASK & 64)) {
            pg8::Gemm g{(const bf16_t*)(ws + WS_SCR), (const bf16_t*)(ws + WS_W3) + (size_t)l * 2 * DFF * DM, MTOK, 2 * DFF, DM}; pg8::StaticOrder S; S.init(MTOK, 2 * DFF, gridDim.x, blockIdx.x);
            EpiSwi E{(bf16_t*)(ws + WS_H), (const float*)(ws + WS_RSS) + (size_t)(2 * l + 1) * MTOK};
            pg8::gemm_phase<EpiSwi, pg8::StaticOrder, true, true>(lds3, g, S, E);
        } else if (PH_MASK & 128) {
            pg8::Gemm g{(const bf16_t*)(ws + WS_H), (const bf16_t*)(ws + WS_WD) + (size_t)l * DM * DFF, MTOK, DM, DFF}; pg8::StaticOrder S; S.init(MTOK, DM, gridDim.x, blockIdx.x);
            EpiRes E{nullptr, (const bf16_t*)(ws + WS_SCR), (l == 0) ? nullptr : p.out, (l == 0) ? (bf16_t*)p.out : nullptr, (l == 0) ? (float*)(ws + WS_RSS) + (size_t)2 * MTOK : nullptr};
            pg8::gemm_phase<EpiRes, pg8::StaticOrder, true, true>(lds3, g, S, E);
        }
        }
    }
}

#ifndef ONE_LAUNCH_X
#define ONE_LAUNCH 1
#endif
extern "C" void kernel_launch(void* const* d_in, const int* in_sizes, int n_in, void* d_out, int out_size, void* d_ws, size_t ws_size, hipStream_t stream) {
    static int grid = 0;
    if (grid == 0) {
        if (n_in != 12 || ws_size < WS_END) { fprintf(stderr, "kernel_launch: unexpected n_in %d / ws %zu\n", n_in, ws_size); grid = -1; return; }
        int dev = 0, cus = 0, per_cu = 0;
        hipGetDevice(&dev); hipDeviceGetAttribute(&cus, hipDeviceAttributeMultiprocessorCount, dev);
        if (hipFuncSetAttribute((const void*)mega_fwd, hipFuncAttributeMaxDynamicSharedMemorySize, LDS_BYTES) != hipSuccess) { fprintf(stderr, "hipFuncSetAttribute failed\n"); grid = -1; return; }
        hipOccupancyMaxActiveBlocksPerMultiprocessor(&per_cu, (const void*)mega_fwd, 512, LDS_BYTES);
        (void)hipGetLastError();
        if (per_cu < 1) per_cu = 1;
        grid = cus * per_cu; if (grid > 256) grid = 256;
    }
    if (grid < 0) return;
    hipMemsetAsync((char*)d_ws + WS_CTL, 0, CTL_BYTES, stream);
    Params p{};
    p.x = (const float*)d_in[0]; p.attn_g = (const float*)d_in[1]; p.w_in = (const float*)d_in[2]; p.qg = (const float*)d_in[3]; p.kg = (const float*)d_in[4];
    p.dlam = (const float*)d_in[5]; p.subln = (const float*)d_in[6]; p.w_out = (const float*)d_in[7]; p.ffn_g = (const float*)d_in[8];
    p.w_gate = (const float*)d_in[9]; p.w_up = (const float*)d_in[10]; p.w_down = (const float*)d_in[11];
    p.out = (float*)d_out; p.ws = (unsigned char*)d_ws;
#if ONE_LAUNCH
    p.ph_lo = 0; p.ph_hi = 16;
    void* args[] = {&p};
    hipError_t e = hipLaunchCooperativeKernel((const void*)mega_fwd, dim3(grid), dim3(512), args, LDS_BYTES, stream);
    if (e != hipSuccess) fprintf(stderr, "cooperative launch failed: %s (grid %d)\n", hipGetErrorString(e), grid);
#else
    for (int ph = 0; ph < 16; ++ph) {
        p.ph_lo = ph; p.ph_hi = ph + 1;
        hipLaunchKernelGGL(mega_fwd, dim3(grid), dim3(512), LDS_BYTES, stream, p);
    }
#endif
}
```

```cpp
#include <hip/hip_runtime.h>
#include <hip/hip_cooperative_groups.h>
#include <cstdio>
#include <cstdint>
#include <cmath>
namespace cg = cooperative_groups;

namespace pg8 {
#define PG8_LAS __attribute__((address_space(3)))
typedef unsigned short bf16_t;
typedef short bf16x8 __attribute__((ext_vector_type(8)));
typedef float f32x4 __attribute__((ext_vector_type(4)));
typedef unsigned u32x4 __attribute__((ext_vector_type(4)));
constexpr int BM = 256, BK = 64, HALF = 128, HTB = HALF * BK * 2  , STAGE_BYTES = 8 * HTB, NXCD = 8, WGM = 8;

__host__ __device__ __forceinline__ int lds_byte(int r, int c) { const int st = (r >> 4) * 2 + (c >> 5), rr = r & 15, cc = c & 31, ob = rr * 64 + cc * 2; return st * 1024 + (ob ^ (((ob >> 9) & 1) << 5)); }
__host__ __device__ __forceinline__ void stage_rc(int b, int& R, int& C) { const int st = b / 1024, sb = b % 1024, swz = sb ^ (((sb >> 9) & 1) << 5); R = (st >> 1) * 16 + swz / 64; C = (st & 1) * 32 + (swz % 64) / 2; }
__host__ __device__ __forceinline__ int perm32(int rho) { const int n = rho >> 4, i = rho & 15; return 8 * (i >> 2) + 4 * n + (i & 3); }

struct Unit { int pm, pn; };
struct Gemm { const bf16_t* A; const bf16_t* Bt; int M, N, K; };

struct StaticOrder {
    int nM, nN, nwg, G, c;
    __host__ __device__ void init(int M, int N, int G_, int c_) { nM = M / BM; nN = N / BM; nwg = nM * nN; G = G_; c = c_; }
    __host__ __device__ bool next(int i, Unit& u) const {
        const long L = (long)i * G + c; if (L >= nwg) return false;
        int wgid = (int)L; { const int q = nwg / NXCD, r = nwg % NXCD, xcd = wgid % NXCD, off = wgid / NXCD; wgid = (xcd < r ? xcd * (q + 1) : r * (q + 1) + (xcd - r) * q) + off; }
        const int nig = WGM * nN, gid = wgid / nig, fm = gid * WGM, gsz = (nM - fm) < WGM ? (nM - fm) : WGM;
        u.pm = fm + ((wgid % nig) % gsz); u.pn = (wgid % nig) / gsz; return true;
    }
    __device__ __forceinline__ void a_ready(const Unit&) const {}
    __device__ __forceinline__ void done(const Unit&) const {}
};

__device__ __forceinline__ unsigned cvt_pk_bf16(float lo, float hi) { unsigned r; asm volatile("v_cvt_pk_bf16_f32 %0, %1, %2" : "=v"(r) : "v"(lo), "v"(hi)); return r; }
typedef float f32x2 __attribute__((ext_vector_type(2)));
template <class Epi, class Sched, bool ALIGN_EPI = false, bool SP2 = false>
__device__ __forceinline__ void gemm_phase(PG8_LAS unsigned char* lds, const Gemm g, const Sched& S, const Epi& E) {
    int tid_ = threadIdx.x; asm volatile("" : "+v"(tid_) :: "memory");
    const int tid = tid_, wid = __builtin_amdgcn_readfirstlane(tid >> 6), lane = tid & 63, wr = wid >> 2, wc = wid & 3, fr = lane & 15, fq = lane >> 4;
    const int K = g.K, nt = K / BK;
    unsigned voffA[2], voffB[2];
#pragma unroll
    for (int i = 0; i < 2; ++i) { int R, C; stage_rc(tid * 16 + i * 8192, R, C); const int Rb = Epi::PERM ? ((R & ~31) + perm32(R & 31)) : R;
        voffA[i] = (unsigned)(R * K + C) * 2u; voffB[i] = (unsigned)(Rb * K + C) * 2u; }
    const size_t kstep = (size_t)(BK * 2);
    const size_t hstep = (size_t)HALF * K * 2;
    const size_t tstep = 2 * hstep;
    const unsigned ldsw = (unsigned)wid * 1024u;
    const int aoff = lds_byte(wr * 64 + fr, fq * 8), boff = lds_byte(wc * 32 + fr, fq * 8);
#define PG8_SA(b, h) (((b) * 2 + (h)) * HTB)
#define PG8_SB(b, h) ((4 + (b) * 2 + (h)) * HTB)
#define PG8_STAGE(bufoff, gbase, voff) do { _Pragma("unroll") for (int _i = 0; _i < 2; ++_i) \
        __builtin_amdgcn_global_load_lds((const unsigned*)((const char*)(gbase) + (voff)[_i]), (PG8_LAS unsigned*)(lds + (bufoff) + ldsw + _i * 8192), 16, 0, 0); } while (0)
#define PG8_LDA(dst, b, h) do { _Pragma("unroll") for (int m = 0; m < 4; ++m) _Pragma("unroll") for (int k = 0; k < 2; ++k) dst[m][k] = *(const PG8_LAS bf16x8*)(lds + PG8_SA(b, h) + aoff + m * 2048 + k * 1024); } while (0)
#define PG8_LDB(dst, b, h) do { _Pragma("unroll") for (int n = 0; n < 2; ++n) _Pragma("unroll") for (int k = 0; k < 2; ++k) dst[n][k] = *(const PG8_LAS bf16x8*)(lds + PG8_SB(b, h) + boff + n * 2048 + k * 1024); } while (0)
#define PG8_MMA(ai, bj, At, Bt) do { __builtin_amdgcn_s_setprio(1); _Pragma("unroll") for (int m = 0; m < 4; ++m) _Pragma("unroll") for (int n = 0; n < 2; ++n) _Pragma("unroll") for (int k = 0; k < 2; ++k) \
        acc[ai][bj][m][n] = __builtin_amdgcn_mfma_f32_16x16x32_bf16(Bt[n][k], At[m][k], acc[ai][bj][m][n], 0, 0, 0); __builtin_amdgcn_s_setprio(0); } while (0)
#define PG8_WAIT_V(n) asm volatile("s_waitcnt vmcnt(" #n ")" ::: "memory")
#define PG8_WAIT_L(n) asm volatile("s_waitcnt lgkmcnt(" #n ")" ::: "memory")
#define PG8_BAR __builtin_amdgcn_s_barrier()
#define PG8_SCHED __builtin_amdgcn_sched_barrier(0)
    Unit cur, nxt; int ui = 0;
    if (!S.next(0, cur)) return;
    f32x4 acc[2][2][4][2];
#pragma unroll
    for (int a = 0; a < 2; ++a)
#pragma unroll
        for (int b = 0; b < 2; ++b)
#pragma unroll
            for (int m = 0; m < 4; ++m)
#pragma unroll
                for (int n = 0; n < 2; ++n) acc[a][b][m][n] = (f32x4){0.f, 0.f, 0.f, 0.f};
    bf16x8 At[4][2], B0[2][2], B1[2][2];
    const char* cA = (const char*)g.A + (size_t)cur.pm * tstep; const char* cB = (const char*)g.Bt + (size_t)cur.pn * tstep;
    S.a_ready(cur);
    if constexpr (SP2) {
        PG8_STAGE(PG8_SB(0, 0), cB, voffB); PG8_STAGE(PG8_SB(0, 1), cB + hstep, voffB); PG8_STAGE(PG8_SA(0, 0), cA, voffA); PG8_STAGE(PG8_SA(0, 1), cA + hstep, voffA);
        if (wr == 1) PG8_BAR;
        PG8_WAIT_V(2); PG8_BAR;
        PG8_STAGE(PG8_SB(1, 0), cB + kstep, voffB); PG8_STAGE(PG8_SA(1, 0), cA + kstep, voffA); PG8_STAGE(PG8_SB(1, 1), cB + hstep + kstep, voffB);
        PG8_WAIT_V(6); PG8_BAR;
    } else {
        PG8_STAGE(PG8_SB(0, 0), cB, voffB); PG8_STAGE(PG8_SA(0, 0), cA, voffA); PG8_STAGE(PG8_SB(0, 1), cB + hstep, voffB); PG8_STAGE(PG8_SA(0, 1), cA + hstep, voffA);
        if (wr == 1) PG8_BAR;
        PG8_WAIT_V(4); PG8_BAR;
        PG8_STAGE(PG8_SB(1, 0), cB + kstep, voffB); PG8_STAGE(PG8_SA(1, 0), cA + kstep, voffA); PG8_STAGE(PG8_SB(1, 1), cB + hstep + kstep, voffB);
        PG8_WAIT_V(6); PG8_BAR;
    }
    for (;;) {
        const bool has_next = S.next(ui + 1, nxt);
        const char* nA = has_next ? (const char*)g.A + (size_t)nxt.pm * tstep : cA; const char* nB = has_next ? (const char*)g.Bt + (size_t)nxt.pn * tstep : cB;
        for (int t = 0; t < nt; t += 2) {
            const bool last = (t == nt - 2);
            const char* a1 = cA + (size_t)(t + 1) * kstep;
            const char* a2 = last ? nA : cA + (size_t)(t + 2) * kstep; const char* b2 = last ? nB : cB + (size_t)(t + 2) * kstep;
            const char* a3 = a2 + kstep; const char* b3 = b2 + kstep;
            if (last && has_next) S.a_ready(nxt);
            if constexpr (SP2) {
            PG8_LDB(B0, 0, 0); PG8_LDB(B1, 0, 1); PG8_SCHED; PG8_LDA(At, 0, 0); PG8_STAGE(PG8_SA(1, 1), a1 + hstep, voffA);
            PG8_WAIT_V(8); PG8_WAIT_L(0); PG8_BAR; PG8_MMA(0, 0, At, B0); PG8_MMA(0, 1, At, B1); PG8_BAR; PG8_SCHED;
            PG8_LDA(At, 0, 1); PG8_STAGE(PG8_SB(0, 0), b2, voffB); PG8_STAGE(PG8_SB(0, 1), b2 + hstep, voffB); PG8_STAGE(PG8_SA(0, 0), a2, voffA);
            PG8_WAIT_V(8); PG8_WAIT_L(0); PG8_BAR; PG8_MMA(1, 0, At, B0); PG8_MMA(1, 1, At, B1); PG8_BAR; PG8_SCHED;
            PG8_LDB(B0, 1, 0); PG8_LDB(B1, 1, 1); PG8_SCHED; PG8_LDA(At, 1, 0); PG8_STAGE(PG8_SA(0, 1), a2 + hstep, voffA);
            PG8_WAIT_V(8); PG8_WAIT_L(0); PG8_BAR; PG8_MMA(0, 0, At, B0); PG8_MMA(0, 1, At, B1); PG8_BAR; PG8_SCHED;
            PG8_LDA(At, 1, 1); PG8_STAGE(PG8_SB(1, 0), b3, voffB); PG8_STAGE(PG8_SB(1, 1), b3 + hstep, voffB); PG8_STAGE(PG8_SA(1, 0), a3, voffA);
            PG8_WAIT_V(8); PG8_WAIT_L(0); PG8_BAR; PG8_MMA(1, 0, At, B0); PG8_MMA(1, 1, At, B1); PG8_BAR; PG8_SCHED;
            } else {
            PG8_LDB(B0, 0, 0); PG8_SCHED; PG8_LDA(At, 0, 0); PG8_STAGE(PG8_SA(1, 1), a1 + hstep, voffA);
            PG8_WAIT_L(8); PG8_BAR; PG8_WAIT_L(0); PG8_MMA(0, 0, At, B0); PG8_BAR; PG8_SCHED;
            PG8_LDB(B1, 0, 1); PG8_STAGE(PG8_SB(0, 0), b2, voffB);
            PG8_BAR; PG8_WAIT_L(0); PG8_MMA(0, 1, At, B1); PG8_BAR;
            PG8_LDA(At, 0, 1); PG8_STAGE(PG8_SA(0, 0), a2, voffA);
            PG8_BAR; PG8_WAIT_L(0); PG8_MMA(1, 0, At, B0); PG8_BAR; PG8_SCHED;
            PG8_STAGE(PG8_SB(0, 1), b2 + hstep, voffB);
            PG8_WAIT_V(6); PG8_BAR; PG8_MMA(1, 1, At, B1); PG8_BAR;
            PG8_LDB(B0, 1, 0); PG8_SCHED; PG8_LDA(At, 1, 0); PG8_STAGE(PG8_SA(0, 1), a2 + hstep, voffA);
            PG8_WAIT_L(8); PG8_BAR; PG8_WAIT_L(0); PG8_MMA(0, 0, At, B0); PG8_BAR; PG8_SCHED;
            PG8_LDB(B1, 1, 1); PG8_STAGE(PG8_SB(1, 0), b3, voffB);
            PG8_BAR; PG8_WAIT_L(0); PG8_MMA(0, 1, At, B1); PG8_BAR;
            PG8_LDA(At, 1, 1); PG8_STAGE(PG8_SA(1, 0), a3, voffA);
            PG8_BAR; PG8_WAIT_L(0); PG8_MMA(1, 0, At, B0); PG8_BAR; PG8_SCHED;
            PG8_STAGE(PG8_SB(1, 1), b3 + hstep, voffB);
            PG8_WAIT_V(6); PG8_BAR; PG8_MMA(1, 1, At, B1); PG8_BAR;
            }
        }
        if constexpr (ALIGN_EPI) { if (wr == 0) PG8_BAR; }
        if constexpr (!Epi::AFTER_DRAIN) { E(acc, cur, wr, wc, fr, fq); S.done(cur); }
        if (!has_next) break;
#pragma unroll
        for (int a = 0; a < 2; ++a)
#pragma unroll
            for (int b = 0; b < 2; ++b)
#pragma unroll
                for (int m = 0; m < 4; ++m)
#pragma unroll
                    for (int n = 0; n < 2; ++n) acc[a][b][m][n] = (f32x4){0.f, 0.f, 0.f, 0.f};
        cur = nxt; cA = nA; cB = nB; ++ui;
        if constexpr (ALIGN_EPI) { if (wr == 1) PG8_BAR; }
    }
    PG8_WAIT_V(0);
    if constexpr (!ALIGN_EPI) { if (wr == 0) PG8_BAR; }
    PG8_BAR;
    if constexpr (Epi::AFTER_DRAIN) { E.fused(acc, cur, wr, wc, fr, fq, lds, wid, lane); S.done(cur); }
#undef PG8_SA
#undef PG8_SB
#undef PG8_STAGE
#undef PG8_LDA
#undef PG8_LDB
#undef PG8_MMA
#undef PG8_WAIT_V
#undef PG8_WAIT_L
#undef PG8_BAR
#undef PG8_SCHED
}
}

#ifndef PH_MASK
#define PH_MASK 255
#endif
#ifndef REP_SKIP_DIFF
#define REP_SKIP_DIFF 1
#endif
#ifndef SEL_REP_SCORE
#define SEL_REP_SCORE 1
#endif
#ifndef SEL_REP_ROWS
#define SEL_REP_ROWS 1
#endif
#ifndef EXTRA_SYNCS
#define EXTRA_SYNCS 0
#endif
#ifndef PROBE_XATOM
#define PROBE_XATOM 0
#endif
#ifndef REP_MASK
#define REP_MASK 0
#endif
#ifndef ONE_LAUNCH
#define ONE_LAUNCH 1
#endif
typedef unsigned short bf16_t;
typedef short bf16x8 __attribute__((ext_vector_type(8)));
typedef short s16x4 __attribute__((ext_vector_type(4)));
typedef float f32x4 __attribute__((ext_vector_type(4)));
typedef float f32x16 __attribute__((ext_vector_type(16)));
typedef unsigned u32x4 __attribute__((ext_vector_type(4)));
typedef unsigned u32x2 __attribute__((ext_vector_type(2)));
typedef __bf16 bf16x2_t __attribute__((ext_vector_type(2)));
typedef float f32x2_t __attribute__((ext_vector_type(2)));
typedef unsigned long long u64;
#define DI __device__ __forceinline__
#define LAS __attribute__((address_space(3)))
#define GAS __attribute__((address_space(1)))
#define MFMA32(a, b, c) __builtin_amdgcn_mfma_f32_32x32x16_bf16((a), (b), (c), 0, 0, 0)
#define NEG_INF (-__builtin_inff())

constexpr int SEQ = 4096, BATCH = 8, DM = 1024, MTOK = BATCH * SEQ, DFF = 2816, INC = 3656;
constexpr int N1A = 2816;
constexpr int NSLOT = 41;
constexpr float EPS = 1e-6f;
constexpr size_t MiB = 1u << 20;
constexpr size_t WS_CTL = 0, CTL_BYTES = 1 * MiB;
constexpr int CW_BAR = 4096;
constexpr size_t WS_KMEAN = 65536;
constexpr size_t WS_RSS = 512 * 1024;
constexpr size_t WS_CS = 1 * MiB;
constexpr size_t WS_IW = 2 * MiB;
constexpr size_t WS_W1A = 4 * MiB, WS_W1B = 15 * MiB, WS_WO = 19 * MiB, WS_W3 = 23 * MiB, WS_WD = 45 * MiB;
constexpr size_t WS_BM = 56 * MiB;
constexpr size_t WS_XB = 72 * MiB;
constexpr size_t WS_QK = 136 * MiB;
constexpr size_t WS_VT = 300 * MiB;
constexpr size_t WS_H = 136 * MiB;
constexpr size_t WS_SCR = 364 * MiB;
constexpr size_t WS_END = 492 * MiB;
constexpr int LDS_BYTES = 147456;

DI unsigned pk2(float lo, float hi) { f32x2_t v = {lo, hi}; bf16x2_t b = __builtin_convertvector(v, bf16x2_t); return __builtin_bit_cast(unsigned, b); }
DI float bf_lo(unsigned u) { return __builtin_bit_cast(float, u << 16); }
DI float bf_hi(unsigned u) { return __builtin_bit_cast(float, u & 0xffff0000u); }
DI int opaque_tid() { int t = threadIdx.x; asm volatile("" : "+v"(t)); return t; }
template <class T> DI T* gp(T* p) { return (T*)(__attribute__((address_space(1))) T*)p; }
DI int crow(int r, int h) { return (r & 3) + 8 * (r >> 2) + 4 * h; }
DI float shx(float v, int m, int lane) { return __builtin_bit_cast(float, __builtin_amdgcn_ds_bpermute((lane ^ m) << 2, __builtin_bit_cast(int, v))); }
DI float wave_sum(float v, int lane) {
#pragma unroll
    for (int o = 1; o < 64; o <<= 1) v += shx(v, o, lane);
    return v;
}

struct Params {
    const float* x; const float* attn_g; const float* w_in; const float* qg; const float* kg; const float* dlam; const float* subln;
    const float* w_out; const float* ffn_g; const float* w_gate; const float* w_up; const float* w_down;
    float* out; unsigned char* ws;
    int ph_lo, ph_hi;
};

struct EpiQK {
    static constexpr bool PERM = true, AFTER_DRAIN = false;
    bf16_t* QK; float* iw; const float* cs; const float* qg; const float* kg; const float* rss;
    DI void head(const pg8::f32x4 (&acc)[2][2][4][2], int row0, int fq, int lane, const float* g, bf16_t* dst) const {
        const bool norm = (g != nullptr);
        f32x4 g00 = {1.f, 1.f, 1.f, 1.f}, g01 = g00, g10 = g00, g11 = g00;
        if (norm) { g00 = *(const f32x4*)(g + 8 * fq); g01 = *(const f32x4*)(g + 8 * fq + 4); g10 = *(const f32x4*)(g + 32 + 8 * fq); g11 = *(const f32x4*)(g + 32 + 8 * fq + 4); }
        f32x4 nc0, nc1, ns0, ns1; float nrs;
        { const int row = row0, pos = row & (SEQ - 1); const float* cp = cs + (size_t)pos * 64 + 8 * fq;
          nc0 = *(const f32x4*)(cp); nc1 = *(const f32x4*)(cp + 4); ns0 = *(const f32x4*)(cp + 32); ns1 = *(const f32x4*)(cp + 36); nrs = rss[row]; }
#pragma unroll
        for (int idx = 0; idx < 8; ++idx) {
                const int ai = idx >> 2, m = idx & 3;
                const int row = row0 + ai * 128 + m * 16;
                const f32x4 c0 = nc0, c1 = nc1, s0 = ns0, s1 = ns1; const float rsv = nrs;
                if (idx < 7) { const int nrow = row0 + ((idx + 1) >> 2) * 128 + ((idx + 1) & 3) * 16, npos = nrow & (SEQ - 1); const float* cp = cs + (size_t)npos * 64 + 8 * fq;
                    nc0 = *(const f32x4*)(cp); nc1 = *(const f32x4*)(cp + 4); ns0 = *(const f32x4*)(cp + 32); ns1 = *(const f32x4*)(cp + 36); nrs = rss[nrow]; }
                const float rr = rsqrtf(rsv * (1.f / DM) + EPS);
                f32x4 a00 = acc[ai][0][m][0] * rr, a01 = acc[ai][0][m][1] * rr, a10 = acc[ai][1][m][0] * rr, a11 = acc[ai][1][m][1] * rr;
                {
                    f32x4 sq = a00 * a00 + a01 * a01 + a10 * a10 + a11 * a11;
                    float ss = (sq[0] + sq[1]) + (sq[2] + sq[3]);
                    ss += shx(ss, 16, lane); ss += shx(ss, 32, lane);
                    const float rn = norm ? rsqrtf(ss * (1.f / 64.f) + EPS) : 1.f;
                    a00 = a00 * rn * g00; a01 = a01 * rn * g01; a10 = a10 * rn * g10; a11 = a11 * rn * g11;
                }
                const f32x4 o00 = a00 * c0 - a10 * s0, o01 = a01 * c1 - a11 * s1, o10 = a00 * s0 + a10 * c0, o11 = a01 * s1 + a11 * c1;
                u32x4 w0, w1;
                w0[0] = pk2(o00[0], o00[1]); w0[1] = pk2(o00[2], o00[3]); w0[2] = pk2(o01[0], o01[1]); w0[3] = pk2(o01[2], o01[3]);
                w1[0] = pk2(o10[0], o10[1]); w1[1] = pk2(o10[2], o10[3]); w1[2] = pk2(o11[0], o11[1]); w1[3] = pk2(o11[2], o11[3]);
                bf16_t* dp = dst + (size_t)row * 64 + 8 * fq;
                *(u32x4*)dp = w0; *(u32x4*)(dp + 32) = w1;
                __builtin_amdgcn_sched_barrier(0);
        }
    }
    DI void operator()(const pg8::f32x4 (&acc)[2][2][4][2], const pg8::Unit& u, int wr, int wc, int fr, int fq) const {
        const int T = u.pn, row0 = u.pm * 256 + wr * 64 + fr;
        if (T == 10 && wc == 1) {
            if (fq == 0) {
#pragma unroll
                for (int ai = 0; ai < 2; ++ai)
#pragma unroll
                    for (int m = 0; m < 4; ++m) {
                        const int row = row0 + ai * 128 + m * 16;
                        const float sc = 0.35355339059f * 0.125f * rsqrtf(rss[row] * (1.f / DM) + EPS);
                        f32x4 a = acc[ai][0][m][0], b = acc[ai][0][m][1];
                        *(f32x4*)(iw + (size_t)row * 8) = a * sc; *(f32x4*)(iw + (size_t)row * 8 + 4) = b * sc;
                    }
            }
            return;
        }
        if (T == 10 && wc > 1) return;
        const int slot = (T == 10) ? 40 : T * 4 + wc;
        const float* g = (T == 0) ? qg : (T == 1) ? kg : (T <= 3) ? qg + 64 : (T <= 5) ? kg + 64 : (T == 6) ? qg + 128 : (T == 7) ? kg + 128 : nullptr;
        head(acc, row0, fq, fr + 16 * fq, g, QK + (size_t)slot * MTOK * 64);
    }
};
struct EpiVT {
    static constexpr bool PERM = true, AFTER_DRAIN = false;
    bf16_t* O; int ldc; const float* rss;
    DI void operator()(const pg8::f32x4 (&acc)[2][2][4][2], const pg8::Unit& u, int wr, int wc, int fr, int fq) const {
        const int row0 = u.pm * 256 + wr * 64 + fr, col0 = u.pn * 256 + wc * 32 + 8 * fq;
        f32x4 r0[2], r1[2];
#pragma unroll
        for (int bj = 0; bj < 2; ++bj) { const f32x4 s0 = *(const f32x4*)(rss + col0 + bj * 128), s1 = *(const f32x4*)(rss + col0 + bj * 128 + 4);
#pragma unroll
            for (int e = 0; e < 4; ++e) { r0[bj][e] = rsqrtf(s0[e] * (1.f / DM) + EPS); r1[bj][e] = rsqrtf(s1[e] * (1.f / DM) + EPS); } }
#pragma unroll
        for (int ai = 0; ai < 2; ++ai)
#pragma unroll
            for (int m = 0; m < 4; ++m) {
                bf16_t* rp = O + (size_t)(row0 + ai * 128 + m * 16) * ldc + col0;
#pragma unroll
                for (int bj = 0; bj < 2; ++bj) {
                    const f32x4 v0 = acc[ai][bj][m][0] * r0[bj], v1 = acc[ai][bj][m][1] * r1[bj];
                    u32x4 w; w[0] = pk2(v0[0], v0[1]); w[1] = pk2(v0[2], v0[3]); w[2] = pk2(v1[0], v1[1]); w[3] = pk2(v1[2], v1[3]);
                    *(u32x4*)(rp + bj * 128) = w;
                }
            }
    }
};
struct EpiRes {
    static constexpr bool PERM = true, AFTER_DRAIN = false;
    const float* srcf; const bf16_t* srcb; float* out; bf16_t* xb; float* rss;
    DI void operator()(const pg8::f32x4 (&acc)[2][2][4][2], const pg8::Unit& u, int wr, int wc, int fr, int fq) const {
        const int row0 = u.pm * 256 + wr * 64 + fr, col0 = u.pn * 256 + wc * 32 + 8 * fq, lane = fr + 16 * fq;
#pragma unroll
        for (int ai = 0; ai < 2; ++ai)
#pragma unroll
            for (int m = 0; m < 4; ++m) {
                const int row = row0 + ai * 128 + m * 16;
                const size_t off = (size_t)row * DM + col0;
                float ss = 0.f;
#pragma unroll
                for (int bj = 0; bj < 2; ++bj) {
                    f32x4 x0, x1;
                    if (srcb) { const u32x4 w = *(const u32x4*)(srcb + off + bj * 128);
                        x0 = (f32x4){bf_lo(w[0]), bf_hi(w[0]), bf_lo(w[1]), bf_hi(w[1])}; x1 = (f32x4){bf_lo(w[2]), bf_hi(w[2]), bf_lo(w[3]), bf_hi(w[3])}; }
                    else { x0 = *(const f32x4*)(srcf + off + bj * 128); x1 = *(const f32x4*)(srcf + off + bj * 128 + 4); }
                    x0 = x0 + acc[ai][bj][m][0]; x1 = x1 + acc[ai][bj][m][1];
                    if (out) { *(f32x4*)(out + off + bj * 128) = x0; *(f32x4*)(out + off + bj * 128 + 4) = x1; }
                    if (xb) { u32x4 w; w[0] = pk2(x0[0], x0[1]); w[1] = pk2(x0[2], x0[3]); w[2] = pk2(x1[0], x1[1]); w[3] = pk2(x1[2], x1[3]); *(u32x4*)(xb + off + bj * 128) = w; }
                    const f32x4 sq = x0 * x0 + x1 * x1; ss += (sq[0] + sq[1]) + (sq[2] + sq[3]);
                }
                if (rss) { ss += shx(ss, 16, lane); ss += shx(ss, 32, lane); if (fq == 0) atomicAdd(rss + row, ss); }
            }
    }
};
struct EpiSwi {
    static constexpr bool PERM = true, AFTER_DRAIN = false;
    bf16_t* H; const float* rss;
    DI void operator()(const pg8::f32x4 (&acc)[2][2][4][2], const pg8::Unit& u, int wr, int wc, int fr, int fq) const {
        const int row0 = u.pm * 256 + wr * 64 + fr, col0 = u.pn * 128 + wc * 32 + 8 * fq;
        float rsv[8];
#pragma unroll
        for (int e = 0; e < 8; ++e) rsv[e] = rss[row0 + (e >> 2) * 128 + (e & 3) * 16];
#pragma unroll
        for (int ai = 0; ai < 2; ++ai)
#pragma unroll
            for (int m = 0; m < 4; ++m) {
                float hv[8];
                const float rr = rsqrtf(rsv[4 * ai + m] * (1.f / DM) + EPS);
#pragma unroll
                for (int n = 0; n < 2; ++n)
#pragma unroll
                    for (int j = 0; j < 4; ++j) {
                        const float g = acc[ai][0][m][n][j] * rr, up = acc[ai][1][m][n][j] * rr;
                        hv[4 * n + j] = g * up * __builtin_amdgcn_rcpf(1.f + __builtin_amdgcn_exp2f(-1.44269504089f * g));
                    }
                u32x4 w; w[0] = pk2(hv[0], hv[1]); w[1] = pk2(hv[2], hv[3]); w[2] = pk2(hv[4], hv[5]); w[3] = pk2(hv[6], hv[7]);
                *(u32x4*)(H + (size_t)(row0 + ai * 128 + m * 16) * DFF + col0) = w;
            }
    }
};

DI void wconv_item(const float* W, int N, int col0, int nvalid, const float* gk, bf16_t* WT, int K, int n0, int k0, LAS float* scr, int lane) {
    const int c = lane & 31;
    const int cc = (c < nvalid) ? c : 0;
    float wv[32], gv[32];
#pragma unroll
    for (int i = 0; i < 32; ++i) { const int kk = 2 * i + (lane >> 5); wv[i] = W[(size_t)(k0 + kk) * N + col0 + cc]; gv[i] = gk ? gk[k0 + kk] : 1.f; }
#pragma unroll
    for (int i = 0; i < 32; ++i) { const int kk = 2 * i + (lane >> 5); scr[kk * 33 + c] = (c < nvalid) ? wv[i] * gv[i] : 0.f; }
    asm volatile("s_waitcnt lgkmcnt(0)" ::: "memory");
    const int ch = lane & 7;
#pragma unroll
    for (int j = 0; j < 4; ++j) {
        const int n = (lane >> 3) + 8 * j; const LAS float* s = scr + (8 * ch) * 33 + n;
        u32x4 o; o[0] = pk2(s[0], s[33]); o[1] = pk2(s[2 * 33], s[3 * 33]); o[2] = pk2(s[4 * 33], s[5 * 33]); o[3] = pk2(s[6 * 33], s[7 * 33]);
        *(u32x4*)(WT + (size_t)(n0 + n) * K + k0 + 8 * ch) = o;
    }
    asm volatile("s_waitcnt lgkmcnt(0)" ::: "memory");
}
DI void map_w1a(int n0, int& col0, int& nvalid) {
    const int T = n0 >> 8, c = n0 & 255, bj = c >> 7, wc = (c >> 5) & 3, d0 = 32 * bj;
    nvalid = 32;
    if (T == 10) { if (wc == 0) col0 = 3584 + d0; else if (wc == 1 && bj == 0) { col0 = 3648; nvalid = 8; } else { col0 = 0; nvalid = 0; } return; }
    const int s = T * 4 + wc;
    int base;
    if (s < 4) base = 0 + 64 * s; else if (s < 8) base = 256 + 64 * (s - 4); else if (s < 16) base = 768 + 64 * (s - 8); else if (s < 24) base = 1280 + 64 * (s - 16);
    else if (s < 28) base = 2304 + 64 * (s - 24); else if (s < 32) base = 2560 + 64 * (s - 28); else base = 3072 + 64 * (s - 32);
    col0 = base + d0;
}
DI void prologue_weights(const Params& p, unsigned char* lds) {
    const int tid = opaque_tid(), lane = tid & 63, wave = __builtin_amdgcn_readfirstlane(tid >> 6);
    LAS float* scr = (LAS float*)((LAS unsigned char*)lds) + wave * (64 * 33);
    const int gw = blockIdx.x * 8 + wave, NGW = gridDim.x * 8;
    constexpr int I1A = 88 * 16, I1B = 32 * 16, IO = 32 * 16, I3 = 176 * 16, ID = 32 * 44, IL = I1A + I1B + IO + I3 + ID;
    unsigned char* ws = p.ws;
    for (int it = gw; it < 2 * IL; it += NGW) {
        const int l = it / IL; int r = it - l * IL;
        if (r < I1A) { const int n0 = (r >> 4) * 32, k0 = (r & 15) * 64; int col0, nv; map_w1a(n0, col0, nv);
            wconv_item(p.w_in + (size_t)l * DM * INC, INC, col0, nv, p.attn_g + l * DM, (bf16_t*)(ws + WS_W1A) + (size_t)l * N1A * DM, DM, n0, k0, scr, lane); continue; }
        r -= I1A;
        if (r < I1B) { const int n0 = (r >> 4) * 32, k0 = (r & 15) * 64;
            const int col0 = n0 < 256 ? 512 + n0 : n0 < 768 ? 1792 + (n0 - 256) : 2816 + (n0 - 768);
            wconv_item(p.w_in + (size_t)l * DM * INC, INC, col0, 32, p.attn_g + l * DM, (bf16_t*)(ws + WS_W1B) + (size_t)l * DM * DM, DM, n0, k0, scr, lane); continue; }
        r -= I1B;
        if (r < IO) { const int n0 = (r >> 4) * 32, k0 = (r & 15) * 64;
            wconv_item(p.w_out + (size_t)l * DM * DM, DM, n0, 32, nullptr, (bf16_t*)(ws + WS_WO) + (size_t)l * DM * DM, DM, n0, k0, scr, lane); continue; }
        r -= IO;
        if (r < I3) { const int n0 = (r >> 4) * 32, k0 = (r & 15) * 64; const int T = n0 >> 8, c = n0 & 255, bj = c >> 7, cc = c & 127;
            const float* W = (bj ? p.w_up : p.w_gate) + (size_t)l * DM * DFF;
            wconv_item(W, DFF, 128 * T + cc, 32, p.ffn_g + l * DM, (bf16_t*)(ws + WS_W3) + (size_t)l * 2 * DFF * DM, DM, n0, k0, scr, lane); continue; }
        r -= I3;
        { const int n0 = (r / 44) * 32, k0 = (r % 44) * 64;
            wconv_item(p.w_down + (size_t)l * DFF * DM, DM, n0, 32, nullptr, (bf16_t*)(ws + WS_WD) + (size_t)l * DM * DFF, DFF, n0, k0, scr, lane); }
    }
    float* cs = (float*)(ws + WS_CS);
    for (int e = blockIdx.x * 512 + tid; e < SEQ * 32; e += gridDim.x * 512) {
        const int pos = e >> 5, i = e & 31;
        const float inv = 1.0f / exp2f((float)i * (13.287712379549449f / 32.f));
        const float ang = (float)pos * inv;
        double t = (double)ang * 0.15915494309189535; t -= __builtin_rint(t);
        const float f = (float)t;
        cs[pos * 64 + i] = __builtin_amdgcn_cosf(f); cs[pos * 64 + 32 + i] = __builtin_amdgcn_sinf(f);
    }
}
DI void norm_rows(const float* src, bf16_t* dst, float* rss) {
    const int tid = opaque_tid(), lane = tid & 63, wave = __builtin_amdgcn_readfirstlane(tid >> 6);
    const int gw = blockIdx.x * 8 + wave, NGW = gridDim.x * 8;
    for (int m = gw; m < MTOK; m += 2 * NGW) {
        const int m2 = (m + NGW < MTOK) ? m + NGW : m;
        const f32x4* xa = (const f32x4*)(src + (size_t)m * DM) + lane; const f32x4* xb2 = (const f32x4*)(src + (size_t)m2 * DM) + lane;
        f32x4 va[4], vb[4]; float sa = 0.f, sb = 0.f;
#pragma unroll
        for (int j = 0; j < 4; ++j) { va[j] = xa[64 * j]; vb[j] = xb2[64 * j]; }
#pragma unroll
        for (int j = 0; j < 4; ++j) { sa += (va[j][0] * va[j][0] + va[j][1] * va[j][1]) + (va[j][2] * va[j][2] + va[j][3] * va[j][3]); sb += (vb[j][0] * vb[j][0] + vb[j][1] * vb[j][1]) + (vb[j][2] * vb[j][2] + vb[j][3] * vb[j][3]); }
        sa = wave_sum(sa, lane); sb = wave_sum(sb, lane);
        if (lane == 0) { rss[m] = sa; rss[m2] = sb; }
        u32x2* oa = (u32x2*)(dst + (size_t)m * DM) + lane; u32x2* ob = (u32x2*)(dst + (size_t)m2 * DM) + lane;
#pragma unroll
        for (int j = 0; j < 4; ++j) { u32x2 w; w[0] = pk2(va[j][0], va[j][1]); w[1] = pk2(va[j][2], va[j][3]); oa[64 * j] = w; u32x2 w2; w2[0] = pk2(vb[j][0], vb[j][1]); w2[1] = pk2(vb[j][2], vb[j][3]); ob[64 * j] = w2; }
    }
}

constexpr int ROWB = 144, VROWB = 264, KS_BYTES = 128 * ROWB, VS_BYTES = 128 * VROWB;
constexpr int LDS_KS = 0, LDS_VS = 2 * KS_BYTES, LDS_TOP = LDS_VS + 3 * VS_BYTES;
constexpr int LDS_BST = LDS_TOP + 64, LDS_MISC = LDS_TOP + 128, LDS_QM = LDS_TOP + 256;
static_assert(LDS_TOP >= 131072 && LDS_QM + 1024 <= 147456, "LDS map");
constexpr float SM_C = 0.125f * 1.44269504089f;

template <int DV, int MODE>
DI void flash_pass(unsigned char* lds, const bf16_t* __restrict__ Qp, const bf16_t* __restrict__ Kp, const bf16_t* __restrict__ VTp, int q0,
                   f32x16 (&o)[DV / 32], float& m_run, float& l_run, unsigned qmask, unsigned umask, const u64* bmrow) {
    const int tid = opaque_tid(), lane = tid & 63, wave = __builtin_amdgcn_readfirstlane(tid >> 6), h = lane >> 5, ql = lane & 31;
    const int qw0 = q0 + 32 * wave, q = qw0 + ql;
    bf16x8 qf[4];
#pragma unroll
    for (int ks = 0; ks < 4; ++ks) qf[ks] = *(const GAS bf16x8*)(Qp + (size_t)q * 64 + 16 * ks + 8 * h);
#pragma unroll
    for (int dt = 0; dt < DV / 32; ++dt)
#pragma unroll
        for (int i = 0; i < 16; ++i) o[dt][i] = 0.f;
    m_run = NEG_INF; l_run = 0.f;
    const int ntile = (q0 + 256) >> 7;
    const int krow = tid >> 3, kch = tid & 7;
    const int vrow = tid >> 4, vch = tid & 15;
    int j = 0;
    if (MODE == 1) { while (j < ntile && !((umask >> (j >> 1)) & 1u)) j += 2; }
    u32x4 kreg[2]; u32x4 vreg[DV / 32]; u64 mreg0 = 0, mreg1 = 0;
    kreg[0] = (u32x4){0u, 0u, 0u, 0u}; kreg[1] = kreg[0];
#pragma unroll
    for (int i = 0; i < DV / 32; ++i) vreg[i] = kreg[0];
#define FL_LOADT(jj) do { const int k0_ = (jj) * 128; \
        kreg[0] = *(const GAS u32x4*)(Kp + (size_t)(k0_ + krow) * 64 + kch * 8); kreg[1] = *(const GAS u32x4*)(Kp + (size_t)(k0_ + 64 + krow) * 64 + kch * 8); \
        _Pragma("unroll") for (int i_ = 0; i_ < DV / 32; ++i_) vreg[i_] = *(const GAS u32x4*)(VTp + (size_t)(vrow + 32 * i_) * MTOK + k0_ + vch * 8); \
        if (MODE == 2) { mreg0 = *(const GAS u64*)(bmrow + 2 * (jj)); mreg1 = *(const GAS u64*)(bmrow + 2 * (jj) + 1); } } while (0)
#define FL_STORET(bb, vbb) do { *(u32x4*)(lds + LDS_KS + (bb) * KS_BYTES + krow * ROWB + kch * 16) = kreg[0]; *(u32x4*)(lds + LDS_KS + (bb) * KS_BYTES + (64 + krow) * ROWB + kch * 16) = kreg[1]; \
        _Pragma("unroll") for (int i_ = 0; i_ < DV / 32; ++i_) { unsigned char* vd_ = lds + LDS_VS + (vbb) * VS_BYTES + (vrow + 32 * i_) * VROWB + vch * 16; \
            *(u32x2*)vd_ = (u32x2){vreg[i_][0], vreg[i_][1]}; *(u32x2*)(vd_ + 8) = (u32x2){vreg[i_][2], vreg[i_][3]}; } } while (0)
#define FL_NEXT(jj, out) do { out = (jj) + 1; if (MODE == 1) { while (out < ntile && !((umask >> (out >> 1)) & 1u)) out = (out | 1) + 1; } } while (0)
    __syncthreads();
    u64 mc0 = 0, mc1 = 0; int jn = ntile, cur = 0, vb = 0;
    const bool grpB = (DV == 64) && (wave >= 4);
    u32x4 pprev[8]; int vprev = -1;
#pragma unroll
    for (int e = 0; e < 8; ++e) pprev[e] = (u32x4){0u, 0u, 0u, 0u};
#define FL_VLOAD(DST, G) do { _Pragma("unroll") for (int dt_ = 0; dt_ < DV / 32; ++dt_) { \
        const unsigned char* vp_ = VS_ + (32 * dt_ + ql) * VROWB + (16 * (G) + 4 * h) * 2; \
        (DST)[2 * dt_] = *(const s16x4*)vp_; (DST)[2 * dt_ + 1] = *(const s16x4*)(vp_ + 16); } } while (0)
#define FL_PV(PW, VBUF) do { const unsigned char* VS_ = lds + LDS_VS + (VBUF) * VS_BYTES; \
        s16x4 fa_[2 * (DV / 32)], fb_[2 * (DV / 32)]; \
        FL_VLOAD(fa_, 0); \
        _Pragma("unroll") for (int g_ = 0; g_ < 8; g_ += 2) { \
            FL_VLOAD(fb_, g_ + 1); \
            { const bf16x8 pb_ = __builtin_bit_cast(bf16x8, (PW)[g_]); \
              _Pragma("unroll") for (int dt_ = 0; dt_ < DV / 32; ++dt_) o[dt_] = MFMA32(__builtin_shufflevector(fa_[2 * dt_], fa_[2 * dt_ + 1], 0, 1, 2, 3, 4, 5, 6, 7), pb_, o[dt_]); } \
            if (g_ + 2 < 8) FL_VLOAD(fa_, g_ + 2); \
            { const bf16x8 pb_ = __builtin_bit_cast(bf16x8, (PW)[g_ + 1]); \
              _Pragma("unroll") for (int dt_ = 0; dt_ < DV / 32; ++dt_) o[dt_] = MFMA32(__builtin_shufflevector(fb_[2 * dt_], fb_[2 * dt_ + 1], 0, 1, 2, 3, 4, 5, 6, 7), pb_, o[dt_]); } \
        } } while (0)
    if (j < ntile) {
        FL_LOADT(j); FL_STORET(0, 0); mc0 = mreg0; mc1 = mreg1;
        FL_NEXT(j, jn);
        if (jn < ntile) FL_LOADT(jn);
    }
    __syncthreads();
    while (j < ntile) {
        if (grpB && vprev >= 0) { FL_PV(pprev, vprev); vprev = -1; }
        const bool selq = (MODE == 1) ? (((qmask >> (j >> 1)) & 1u) != 0u) : true;
        u64 selb = ~0ull;
        if (MODE == 1) selb = __ballot(selq);
        const int k0 = j * 128;
        if ((k0 <= qw0 + 31) && (selb != 0ull)) {
            const unsigned char* KS = lds + LDS_KS + cur * KS_BYTES;
            f32x16 st[4];
#pragma unroll
            for (int t = 0; t < 4; ++t)
#pragma unroll
                for (int i = 0; i < 16; ++i) st[t][i] = 0.f;
#pragma unroll
            for (int t = 0; t < 4; ++t)
#pragma unroll
                for (int ks = 0; ks < 4; ++ks) {
                    const bf16x8 ka = *(const bf16x8*)(KS + (32 * t + ql) * ROWB + (16 * ks + 8 * h) * 2);
                    st[t] = MFMA32(ka, qf[ks], st[t]);
                }
            if (MODE == 2) {
#pragma unroll
                for (int t = 0; t < 4; ++t) {
                    const u64 mcur = (t >> 1) ? mc1 : mc0;
                    const unsigned wsel = (unsigned)((t & 1) ? (mcur >> 32) : mcur) >> (4 * h);
#pragma unroll
                    for (int i = 0; i < 16; ++i) { const int kr = (i & 3) + 8 * (i >> 2); st[t][i] = (((wsel >> kr) & 1u) != 0u) ? st[t][i] : NEG_INF; }
                }
            } else {
                const bool need_mask = (k0 + 127 > qw0) || (MODE == 1 && selb != ~0ull);
                if (need_mask) {
                    const int dq = q - k0 - 4 * h;
#pragma unroll
                    for (int t = 0; t < 4; ++t)
#pragma unroll
                        for (int i = 0; i < 16; ++i) { const int kr = (i & 3) + 8 * (i >> 2) + 32 * t; st[t][i] = (selq && (kr <= dq)) ? st[t][i] : NEG_INF; }
                }
            }
            float mx = fmaxf(st[0][0], st[1][0]);
#pragma unroll
            for (int i = 0; i < 16; ++i) mx = fmaxf(fmaxf(mx, st[0][i]), fmaxf(st[1][i], fmaxf(st[2][i], st[3][i])));
            mx = fmaxf(mx, shx(mx, 32, lane)) * SM_C;
            const float m_new = fmaxf(m_run, mx), m_use = (m_new == NEG_INF) ? 0.f : m_new;
            const float alpha = __builtin_amdgcn_exp2f(m_run - m_use);
            const f32x2_t c2 = {SM_C, SM_C}, nm2 = {-m_use, -m_use};
            f32x2_t ps2 = {0.f, 0.f};
#pragma unroll
            for (int t = 0; t < 4; ++t)
#pragma unroll
                for (int i = 0; i < 16; i += 2) {
                    f32x2_t a2 = {st[t][i], st[t][i + 1]};
                    a2 = a2 * c2 + nm2;
                    f32x2_t e2; e2[0] = __builtin_amdgcn_exp2f(a2[0]); e2[1] = __builtin_amdgcn_exp2f(a2[1]);
                    st[t][i] = e2[0]; st[t][i + 1] = e2[1]; ps2 = ps2 + e2;
                }
            l_run = l_run * alpha + (ps2[0] + ps2[1]);
            if (__ballot(m_new > m_run) != 0ull) {
#pragma unroll
                for (int dt = 0; dt < DV / 32; ++dt) o[dt] = o[dt] * alpha;
            }
            m_run = m_new;
#pragma unroll
            for (int t = 0; t < 4; ++t)
#pragma unroll
                for (int s2 = 0; s2 < 2; ++s2) {
                    pprev[2 * t + s2][0] = pk2(st[t][8 * s2], st[t][8 * s2 + 1]); pprev[2 * t + s2][1] = pk2(st[t][8 * s2 + 2], st[t][8 * s2 + 3]);
                    pprev[2 * t + s2][2] = pk2(st[t][8 * s2 + 4], st[t][8 * s2 + 5]); pprev[2 * t + s2][3] = pk2(st[t][8 * s2 + 6], st[t][8 * s2 + 7]);
                }
            if (!grpB) { FL_PV(pprev, vb); } else vprev = vb;
        }
        int jnn = ntile; u64 mn0 = 0, mn1 = 0;
        const int vbn = (vb == 2) ? 0 : vb + 1;
        if (jn < ntile) { FL_STORET(cur ^ 1, vbn); mn0 = mreg0; mn1 = mreg1; FL_NEXT(jn, jnn); if (jnn < ntile) FL_LOADT(jnn); }
        asm volatile("s_waitcnt lgkmcnt(0)\n\ts_barrier" ::: "memory");
        j = jn; jn = jnn; cur ^= 1; vb = vbn; mc0 = mn0; mc1 = mn1;
    }
    if (grpB && vprev >= 0) { FL_PV(pprev, vprev); }
#undef FL_PV
#undef FL_VLOAD
#undef FL_LOADT
#undef FL_STORET
#undef FL_NEXT
}

DI u32x4 widen_pair(u32x2 a  , u32x2 b  ) {
    const auto r0 = __builtin_amdgcn_permlane32_swap(a[0], b[0], false, false);
    const auto r1 = __builtin_amdgcn_permlane32_swap(a[1], b[1], false, false);
    return (u32x4){r0[0], r1[0], r0[1], r1[1]};
}
DI void write_o64(const f32x16 (&o)[2], float l_run, bf16_t* mixrow  , int wave, int lane) {
    const int h = lane >> 5, ql = lane & 31;
    const float inv = 1.f / (l_run + shx(l_run, 32, lane));
    bf16_t* rp = mixrow + (size_t)(32 * wave + ql) * DM;
#pragma unroll
    for (int dt = 0; dt < 2; ++dt)
#pragma unroll
        for (int pr = 0; pr < 2; ++pr) {
            u32x2 a, b2;
            a[0] = pk2(o[dt][8 * pr] * inv, o[dt][8 * pr + 1] * inv); a[1] = pk2(o[dt][8 * pr + 2] * inv, o[dt][8 * pr + 3] * inv);
            b2[0] = pk2(o[dt][8 * pr + 4] * inv, o[dt][8 * pr + 5] * inv); b2[1] = pk2(o[dt][8 * pr + 6] * inv, o[dt][8 * pr + 7] * inv);
            *(GAS u32x4*)(rp + 32 * dt + 16 * pr + 8 * h) = widen_pair(a, b2);
        }
}

DI void moba_unit(const Params& p, unsigned char* lds, int l, int b, int hh, int cur) {
    const int tid = opaque_tid(), lane = tid & 63, wave = __builtin_amdgcn_readfirstlane(tid >> 6);
    const bf16_t* QK = gp((const bf16_t*)(p.ws + WS_QK));
    const bf16_t* Qp = QK + ((size_t)(0 + hh) * MTOK + (size_t)b * SEQ) * 64;
    const bf16_t* Kp = QK + ((size_t)(4 + hh) * MTOK + (size_t)b * SEQ) * 64;
    const bf16_t* VTp = gp((const bf16_t*)(p.ws + WS_VT)) + (size_t)(64 * hh) * MTOK + (size_t)b * SEQ;
    const float* kmean = gp((const float*)(p.ws + WS_KMEAN)) + (size_t)l * 32768;
    volatile unsigned* QM = (volatile unsigned*)(lds + LDS_QM); unsigned* MISC = (unsigned*)(lds + LDS_MISC);
    const int q0 = cur * 256;
    float* kml = (float*)(lds + LDS_KS);
    for (int e = tid; e < cur * 64; e += 512) kml[e] = kmean[((size_t)(b * 16 + (e >> 6)) * 4 + hh) * 64 + (e & 63)];
    __syncthreads();
    if (tid < 256) {
        const u32x4* qr = (const u32x4*)(Qp + (size_t)(q0 + tid) * 64);
        float qv[64];
#pragma unroll
        for (int c = 0; c < 8; ++c) { const u32x4 w = qr[c];
#pragma unroll
            for (int e = 0; e < 4; ++e) { qv[8 * c + 2 * e] = bf_lo(w[e]); qv[8 * c + 2 * e + 1] = bf_hi(w[e]); } }
        float b0 = NEG_INF, b1 = NEG_INF, b2 = NEG_INF; int i0 = -1, i1 = -1, i2 = -1;
        for (int n = 0; n < cur; ++n) {
            const f32x4* km = (const f32x4*)(kml + n * 64);
            float g = 0.f;
#pragma unroll
            for (int d4 = 0; d4 < 16; ++d4) { const f32x4 k4 = km[d4]; g = fmaf(qv[4 * d4], k4[0], g); g = fmaf(qv[4 * d4 + 1], k4[1], g); g = fmaf(qv[4 * d4 + 2], k4[2], g); g = fmaf(qv[4 * d4 + 3], k4[3], g); }
            if (g > b0) { b2 = b1; i2 = i1; b1 = b0; i1 = i0; b0 = g; i0 = n; }
            else if (g > b1) { b2 = b1; i2 = i1; b1 = g; i1 = n; }
            else if (g > b2) { b2 = g; i2 = n; }
        }
        unsigned mask = 1u << cur;
        if (i0 >= 0) mask |= 1u << i0; if (i1 >= 0) mask |= 1u << i1; if (i2 >= 0) mask |= 1u << i2;
        QM[tid] = mask; atomicOr(&MISC[1], mask);
    }
    __syncthreads();
    const unsigned umask = MISC[1], qmask = QM[32 * wave + (lane & 31)];
    f32x16 o[2]; float m_run, l_run;
    flash_pass<64, 1>(lds, Qp, Kp, VTp, q0, o, m_run, l_run, qmask, umask, nullptr);
    write_o64(o, l_run, gp((bf16_t*)p.out + (size_t)MTOK * DM) + ((size_t)b * SEQ + q0) * DM + 64 * hh, wave, lane);
}

DI void dsa_unit(const Params& p, unsigned char* lds, int b, int hh, int cur) {
    const int tid = opaque_tid(), lane = tid & 63, wave = __builtin_amdgcn_readfirstlane(tid >> 6);
    const bf16_t* QK = gp((const bf16_t*)(p.ws + WS_QK));
    const bf16_t* Qp = QK + ((size_t)(24 + hh) * MTOK + (size_t)b * SEQ) * 64;
    const bf16_t* Kp = QK + ((size_t)(28 + hh) * MTOK + (size_t)b * SEQ) * 64;
    const bf16_t* VTp = gp((const bf16_t*)(p.ws + WS_VT)) + (size_t)(768 + 64 * hh) * MTOK + (size_t)b * SEQ;
    const int q0 = cur * 256;
    const u64* bmrow = gp((const u64*)(p.ws + WS_BM)) + ((size_t)b * SEQ + q0 + 32 * wave + (lane & 31)) * 64;
    f32x16 o[2]; float m_run, l_run;
    flash_pass<64, 2>(lds, Qp, Kp, VTp, q0, o, m_run, l_run, 0u, 0u, bmrow);
    write_o64(o, l_run, gp((bf16_t*)p.out + (size_t)MTOK * DM) + ((size_t)b * SEQ + q0) * DM + 768 + 64 * hh, wave, lane);
}

DI void diff_unit(const Params& p, unsigned char* lds, int l, int b, int hh, int cur) {
    const int tid = opaque_tid(), lane = tid & 63, wave = __builtin_amdgcn_readfirstlane(tid >> 6), h = lane >> 5, ql = lane & 31;
    const bf16_t* QK = gp((const bf16_t*)(p.ws + WS_QK));
    const bf16_t* VTp = gp((const bf16_t*)(p.ws + WS_VT)) + (size_t)(256 + 128 * hh) * MTOK + (size_t)b * SEQ;
    const int q0 = cur * 256;
    f32x16 o1[4]; float m1, l1;
    float* sto = gp((float*)(p.ws + WS_SCR)) + (size_t)blockIdx.x * (32 * SEQ) + (size_t)(32 * wave + ql) * 128;
    flash_pass<128, 0>(lds, QK + ((size_t)(8 + 2 * hh) * MTOK + (size_t)b * SEQ) * 64, QK + ((size_t)(16 + 2 * hh) * MTOK + (size_t)b * SEQ) * 64, VTp, q0, o1, m1, l1, 0u, 0u, nullptr);
    {
        const float r1 = 1.f / (l1 + shx(l1, 32, lane));
#pragma unroll
        for (int dt = 0; dt < 4; ++dt)
#pragma unroll
            for (int g = 0; g < 4; ++g) { f32x4 v = {o1[dt][4 * g] * r1, o1[dt][4 * g + 1] * r1, o1[dt][4 * g + 2] * r1, o1[dt][4 * g + 3] * r1}; *(f32x4*)(sto + 32 * dt + 8 * g + 4 * h) = v; }
    }
    flash_pass<128, 0>(lds, QK + ((size_t)(9 + 2 * hh) * MTOK + (size_t)b * SEQ) * 64, QK + ((size_t)(17 + 2 * hh) * MTOK + (size_t)b * SEQ) * 64, VTp, q0, o1, m1, l1, 0u, 0u, nullptr);
    const float* lp = p.dlam + l * 256;
    float d1 = 0.f, d2 = 0.f;
    for (int d = 0; d < 64; ++d) { d1 = fmaf(lp[d], lp[64 + d], d1); d2 = fmaf(lp[128 + d], lp[192 + d], d2); }
    const float lam_init = (l == 0) ? 0.2f : (0.8f - 0.6f * 0.7408182206817179f);
    const float lam = expf(d1) - expf(d2) + lam_init;
    const float r2 = lam / (l1 + shx(l1, 32, lane));
    float ss = 0.f;
#pragma unroll
    for (int dt = 0; dt < 4; ++dt)
#pragma unroll
        for (int g = 0; g < 4; ++g) {
            const f32x4 a = *(const f32x4*)(sto + 32 * dt + 8 * g + 4 * h);
#pragma unroll
            for (int e = 0; e < 4; ++e) { const float v = a[e] - o1[dt][4 * g + e] * r2; o1[dt][4 * g + e] = v; ss = fmaf(v, v, ss); }
        }
    ss += shx(ss, 32, lane);
    const float rn = rsqrtf(ss * (1.f / 128.f) + EPS) * (1.f - lam_init);
    const float* sg = p.subln + l * 128;
    bf16_t* rp = gp((bf16_t*)p.out + (size_t)MTOK * DM) + ((size_t)b * SEQ + q0 + 32 * wave + ql) * DM + 256 + 128 * hh;
#pragma unroll
    for (int dt = 0; dt < 4; ++dt)
#pragma unroll
        for (int pr = 0; pr < 2; ++pr) {
            u32x2 ab[2];
#pragma unroll
            for (int e = 0; e < 2; ++e) {
                const int g = 2 * pr + e, d0 = 32 * dt + 8 * g + 4 * h;
                const f32x4 gv = *(const f32x4*)(sg + d0);
                ab[e][0] = pk2(o1[dt][4 * g] * rn * gv[0], o1[dt][4 * g + 1] * rn * gv[1]); ab[e][1] = pk2(o1[dt][4 * g + 2] * rn * gv[2], o1[dt][4 * g + 3] * rn * gv[3]);
            }
            *(GAS u32x4*)(rp + 32 * dt + 16 * pr + 8 * h) = widen_pair(ab[0], ab[1]);
        }
}

DI unsigned ord_key(float v) { v += 0.f; const unsigned b = __builtin_bit_cast(unsigned, v); return b ^ ((b & 0x80000000u) ? 0xffffffffu : 0x80000000u); }
constexpr int LDS_SEL = 61440, SEL_STRIDE = 6144;
DI float key_f(unsigned u) { const unsigned b = (u & 0x80000000u) ? (u ^ 0x80000000u) : ~u; return __builtin_bit_cast(float, b); }
DI void select_unit(const Params& p, unsigned char* lds, int b, int q0) {
    const int tid = opaque_tid(), lane = tid & 63, wave = __builtin_amdgcn_readfirstlane(tid >> 6);
    float* scr = gp((float*)(p.ws + WS_SCR)) + (size_t)blockIdx.x * (32 * SEQ);
    u64* bm = gp((u64*)(p.ws + WS_BM));
    if (q0 >= 256) {
        const bf16_t* QK = gp((const bf16_t*)(p.ws + WS_QK));
        const bf16_t* IK = QK + ((size_t)40 * MTOK + (size_t)b * SEQ) * 64;
        const int qi = lane & 15, kq = lane >> 4, qrow = 16 * (wave >> 2) + qi, kw = wave & 3;
        const float* iwp = gp((const float*)(p.ws + WS_IW)) + ((size_t)b * SEQ + q0 + qrow) * 8;
        bf16x8 qf[8][2]; float w[8];
        const f32x4 wa = *(const f32x4*)iwp, wb = *(const f32x4*)(iwp + 4);
#pragma unroll
        for (int e = 0; e < 4; ++e) { w[e] = wa[e]; w[4 + e] = wb[e]; }
#pragma unroll
        for (int hh = 0; hh < 8; ++hh)
#pragma unroll
            for (int ks = 0; ks < 2; ++ks) qf[hh][ks] = *(const bf16x8*)(QK + ((size_t)(32 + hh) * MTOK + (size_t)b * SEQ + q0 + qrow) * 64 + 32 * ks + 8 * kq);
        const int n32 = (q0 + 32) >> 5;
        const bf16_t* kbase = IK + (size_t)qi * 64 + 8 * kq;
        for (int srep = 0; srep < SEL_REP_SCORE; ++srep) {
        bf16x8 kf[2][2];
        if (kw < n32) {
#pragma unroll
            for (int sub = 0; sub < 2; ++sub)
#pragma unroll
                for (int ks = 0; ks < 2; ++ks) kf[sub][ks] = *(const GAS bf16x8*)(kbase + (size_t)(32 * kw + 16 * sub) * 64 + 32 * ks);
        }
#pragma unroll 1
        for (int t = kw; t < n32; t += 4) {
            const int k0 = 32 * t;
            bf16x8 kn[2][2];
            const int tn = (t + 4 < n32) ? t + 4 : t;
#pragma unroll
            for (int sub = 0; sub < 2; ++sub)
#pragma unroll
                for (int ks = 0; ks < 2; ++ks) kn[sub][ks] = *(const GAS bf16x8*)(kbase + (size_t)(32 * tn + 16 * sub) * 64 + 32 * ks);
            f32x4 sc[2];
#pragma unroll
            for (int sub = 0; sub < 2; ++sub) sc[sub] = (f32x4){0.f, 0.f, 0.f, 0.f};
#pragma unroll
            for (int hh = 0; hh < 8; ++hh)
#pragma unroll
                for (int sub = 0; sub < 2; ++sub) {
                    f32x4 a = {0.f, 0.f, 0.f, 0.f};
                    a = __builtin_amdgcn_mfma_f32_16x16x32_bf16(kf[sub][0], qf[hh][0], a, 0, 0, 0);
                    a = __builtin_amdgcn_mfma_f32_16x16x32_bf16(kf[sub][1], qf[hh][1], a, 0, 0, 0);
#pragma unroll
                    for (int i = 0; i < 4; ++i) sc[sub][i] = fmaf(w[hh], fmaxf(a[i], 0.f), sc[sub][i]);
                    if (sub == 1 && (hh & 3) == 3) __builtin_amdgcn_sched_barrier(0);
                }
#pragma unroll
            for (int sub = 0; sub < 2; ++sub) *(GAS f32x4*)(scr + (size_t)qrow * SEQ + k0 + 16 * sub + 4 * kq) = sc[sub];
#pragma unroll
            for (int sub = 0; sub < 2; ++sub)
#pragma unroll
                for (int ks = 0; ks < 2; ++ks) kf[sub][ks] = kn[sub][ks];
        }
        }
        __syncthreads();
    }
    LAS unsigned* hist = (LAS unsigned*)((LAS unsigned char*)lds + LDS_SEL + wave * SEL_STRIDE + 16);
    LAS float* listv = (LAS float*)(hist + 1024);
    LAS int* listi = (LAS int*)(hist + 1088);
    LAS unsigned* misc = hist + 1152;
#define SEL_CB() asm volatile("" ::: "memory")
#define SEL_WAIT() asm volatile("s_waitcnt lgkmcnt(0)" ::: "memory")
#pragma unroll 1
    for (int rr0 = 0; rr0 < 4 * SEL_REP_ROWS; ++rr0) {
        const int rr = rr0 & 3;
        const int r = wave * 4 + rr, qpos = q0 + r;
        int ln = lane; asm volatile("" : "+v"(ln));
        u64* bmr = bm + ((size_t)b * SEQ + qpos) * 64;
        if (qpos < 256) {
            const int rem = qpos - ln * 64;
            bmr[ln] = (rem >= 63) ? ~0ull : (rem < 0) ? 0ull : ((2ull << rem) - 1ull);
            continue;
        }
        const int ng = (qpos >> 9) + 1;
        float v[64];
        const float* sr = scr + (size_t)r * SEQ;
#pragma unroll
        for (int g8 = 0; g8 < 8; ++g8) {
#pragma unroll
            for (int jj = 0; jj < 8; ++jj) v[8 * g8 + jj] = NEG_INF;
            if (g8 < ng) {
#pragma unroll
                for (int jj = 0; jj < 8; ++jj) { const int j = 8 * g8 + jj; const float t = *(const GAS float*)(sr + 64 * j + ln); v[j] = (ln <= qpos - 64 * j) ? (t + 0.f) : NEG_INF; }
            }
        }
        float lmax = NEG_INF, lmin = -NEG_INF;
#pragma unroll
        for (int g8 = 0; g8 < 8; ++g8) {
            if (g8 < ng) {
#pragma unroll
                for (int jj = 0; jj < 8; ++jj) { const int j = 8 * g8 + jj; lmax = fmaxf(lmax, v[j]); lmin = fminf(lmin, (v[j] == NEG_INF) ? -NEG_INF : v[j]); }
            }
        }
        SEL_WAIT();
        if (ln == 0) { misc[0] = 0u; misc[1] = 0xffffffffu; misc[2] = 0u; }
        {
            LAS u32x4* hz = (LAS u32x4*)(hist + 16 * ln);
            const u32x4 z = {0u, 0u, 0u, 0u};
            hz[0] = z; hz[1] = z; hz[2] = z; hz[3] = z;
        }
        SEL_CB();
        atomicMax((unsigned*)&misc[0], ord_key(lmax)); atomicMin((unsigned*)&misc[1], ord_key(lmin));
        SEL_WAIT();
        const float hi = key_f(misc[0]), lo = key_f(misc[1]);
        const float inv = 1024.f / (hi - lo), c0 = -lo * inv;
        bool fast = (hi > lo) && (inv < 1e37f);
        float Tv = 0.f; int Ti = 0;
        if (fast) {
            unsigned pb[32];
#pragma unroll
            for (int e = 0; e < 32; ++e) pb[e] = 0u;
#pragma unroll
            for (int g8 = 0; g8 < 8; ++g8) {
                if (g8 < ng) {
#pragma unroll
                    for (int jj = 0; jj < 8; ++jj) { const int j = 8 * g8 + jj;
                        int bin = (int)fmaf(v[j], inv, c0); bin = bin < -1 ? -1 : (bin > 1023 ? 1023 : bin);
                        atomicAdd((unsigned*)(hist + bin), 1u);
                        for (int xa = 0; xa < PROBE_XATOM; ++xa) atomicAdd((unsigned*)(hist + bin), 0u);
                        pb[j >> 1] |= (unsigned)(bin + 1) << (16 * (j & 1)); }
                }
            }
            SEL_WAIT();
            unsigned c[16]; unsigned tot = 0;
            {
                LAS u32x4* hz = (LAS u32x4*)(hist + 16 * ln);
#pragma unroll
                for (int e = 0; e < 4; ++e) { const u32x4 t4 = hz[e]; c[4 * e] = t4[0]; c[4 * e + 1] = t4[1]; c[4 * e + 2] = t4[2]; c[4 * e + 3] = t4[3]; tot += t4[0] + t4[1] + t4[2] + t4[3]; }
            }
            unsigned suf = tot;
#pragma unroll
            for (int d = 1; d < 64; d <<= 1) { const unsigned o = (unsigned)__builtin_amdgcn_ds_bpermute(((ln + d) & 63) << 2, (int)suf); suf += (ln + d < 64) ? o : 0u; }
            const u64 ge = __ballot(suf >= 256u);
            const int Ls = 63 - __builtin_clzll(ge);
            unsigned cum = suf - tot; int bsel = 0; unsigned above = 0, cstar = 0; bool found = false;
#pragma unroll
            for (int t = 15; t >= 0; --t) { if (!found && cum + c[t] >= 256u) { found = true; bsel = 16 * ln + t; above = cum; cstar = c[t]; } cum += c[t]; }
            const int bstar = __builtin_amdgcn_readlane(bsel, Ls); const int need = 256 - __builtin_amdgcn_readlane((int)above, Ls); const int ncand = __builtin_amdgcn_readlane((int)cstar, Ls);
            if (ncand > 64) fast = false;
            else {
                SEL_CB();
                const unsigned blo = (unsigned)(bstar + 1), bhi = blo << 16;
#pragma unroll
                for (int g8 = 0; g8 < 8; ++g8) {
                    if (g8 < ng) {
#pragma unroll
                        for (int jj = 0; jj < 8; ++jj) { const int j = 8 * g8 + jj;
                            const bool is = (j & 1) ? ((pb[j >> 1] & 0xffff0000u) == bhi) : ((pb[j >> 1] & 0xffffu) == blo);
                            if (is) { const unsigned pos = atomicAdd((unsigned*)&misc[2], 1u); listv[pos & 63] = v[j]; listi[pos & 63] = 64 * j + ln; } }
                    }
                }
                SEL_WAIT();
                const float mv = listv[ln]; const int mi = listi[ln];
                int rank = 0;
                for (int i = 0; i < ncand; ++i) { const float ov = listv[i]; const int oi = listi[i]; rank += ((ov > mv) || (ov == mv && oi < mi)) ? 1 : 0; }
                const u64 hit = __ballot(ln < ncand && rank == need - 1);
                const int Lt = __builtin_ctzll(hit);
                Tv = __builtin_bit_cast(float, __builtin_amdgcn_readlane(__builtin_bit_cast(int, mv), Lt)); Ti = __builtin_amdgcn_readlane(mi, Lt);
            }
        }
        if (!fast) {
            unsigned T = 0u;
#pragma unroll 1
            for (int bit = 31; bit >= 0; --bit) {
                const unsigned cand = T | (1u << bit);
                int cc = 0;
#pragma unroll
                for (int j = 0; j < 64; ++j) cc += (v[j] != NEG_INF && ord_key(v[j]) >= cand) ? 1 : 0;
                int totc = 0;
#pragma unroll
                for (int bb = 0; bb < 7; ++bb) totc += __builtin_popcountll(__ballot((cc >> bb) & 1)) << bb;
                if (totc >= 256) T = cand;
            }
            Tv = key_f(T);
            int cc = 0;
#pragma unroll
            for (int j = 0; j < 64; ++j) cc += (v[j] > Tv) ? 1 : 0;
            int cgt = 0;
#pragma unroll
            for (int bb = 0; bb < 7; ++bb) cgt += __builtin_popcountll(__ballot((cc >> bb) & 1)) << bb;
            const int need = 256 - cgt;
            int taken = 0; Ti = -1;
#pragma unroll
            for (int j = 0; j < 64; ++j) {
                const u64 eq = __ballot(v[j] == Tv);
                const int ce = __builtin_popcountll(eq);
                if (Ti < 0 && taken + ce >= need) {
                    int k = need - taken; u64 e = eq; int lanepos = 0;
                    while (k > 0) { lanepos = __builtin_ctzll(e); e &= e - 1; --k; }
                    Ti = 64 * j + lanepos;
                }
                taken += ce;
            }
        }
        unsigned wlo = 0u, whi = 0u;
#pragma unroll
        for (int g8 = 0; g8 < 8; ++g8) {
            if (g8 < ng) {
#pragma unroll
                for (int jj = 0; jj < 8; ++jj) { const int j = 8 * g8 + jj;
                    const u64 word = __ballot((v[j] > Tv) || (v[j] == Tv && ln <= Ti - 64 * j));
                    if (ln == j) { wlo = (unsigned)word; whi = (unsigned)(word >> 32); } }
            }
        }
        *(GAS u64*)(bmr + ln) = (u64)wlo | ((u64)whi << 32);
    }
#undef SEL_CB
#undef SEL_WAIT
}

DI void kmean_unit(const Params& p, unsigned char* lds, int l, int b, int hh, int blk) {
    const int tid = opaque_tid(), lane = tid & 63, wave = __builtin_amdgcn_readfirstlane(tid >> 6), ch = tid & 7, rg = tid >> 3;
    const bf16_t* Kp = gp((const bf16_t*)(p.ws + WS_QK)) + ((size_t)(4 + hh) * MTOK + (size_t)b * SEQ + blk * 256) * 64;
    float a[8];
#pragma unroll
    for (int e = 0; e < 8; ++e) a[e] = 0.f;
#pragma unroll
    for (int i = 0; i < 4; ++i) { const u32x4 w = *(const u32x4*)(Kp + (size_t)(rg + 64 * i) * 64 + ch * 8);
#pragma unroll
        for (int e = 0; e < 4; ++e) { a[2 * e] += bf_lo(w[e]); a[2 * e + 1] += bf_hi(w[e]); } }
#pragma unroll
    for (int e = 0; e < 8; ++e) { float v = a[e]; v += shx(v, 8, lane); v += shx(v, 16, lane); v += shx(v, 32, lane); a[e] = v; }
    float* red = (float*)(lds + LDS_KS);
    if (lane < 8) {
#pragma unroll
        for (int e = 0; e < 8; ++e) red[wave * 64 + lane * 8 + e] = a[e];
    }
    __syncthreads();
    if (tid < 64) { float sacc = 0.f;
#pragma unroll
        for (int w = 0; w < 8; ++w) sacc += red[w * 64 + tid];
        (gp((float*)(p.ws + WS_KMEAN)))[(size_t)l * 32768 + ((size_t)(b * 16 + blk) * 4 + hh) * 64 + tid] = sacc * (1.f / 256.f); }
}

#define XB_TMO      128
#define XB_XCNT(j)  (256  + 64 * (j))
#define XB_XSUB(j)  (1280 + 64 * (j))
#define XB_XGEN(j)  (2304 + 64 * (j))
#define XB_TOP      3328
#define XB_TOPGEN   3392
#define XCD_BAR_WORDS 3456
#define XB_SPIN_CAP (1u << 18)

__device__ __forceinline__ unsigned xb_ld(unsigned* p)              { return __hip_atomic_load(p, __ATOMIC_RELAXED, __HIP_MEMORY_SCOPE_AGENT); }
__device__ __forceinline__ unsigned xb_add(unsigned* p, unsigned v) { return __hip_atomic_fetch_add(p, v, __ATOMIC_RELAXED, __HIP_MEMORY_SCOPE_AGENT); }
__device__ __forceinline__ unsigned xb_xcc_id() { return (unsigned)__builtin_amdgcn_s_getreg((3 << 11) | 20) & 0xFu; }
#define XB_SPIN(cond, bar) do { unsigned _sp = 0; while (cond) { __builtin_amdgcn_s_sleep(1); \
    if ((++_sp & 255u) == 0u) { if (xb_ld(&(bar)[XB_TMO])) break; if (_sp > XB_SPIN_CAP) { atomicAdd(&(bar)[XB_TMO], 1u); break; } } } } while (0)

struct XcdBarrier {
    unsigned* bar; unsigned x;
    volatile LAS unsigned* st;
};

__device__ __forceinline__ XcdBarrier xcd_barrier_post(unsigned* bar, volatile LAS unsigned* st) {
    XcdBarrier b; b.bar = bar; b.x = xb_xcc_id(); b.st = st;
    if (threadIdx.x == 0) (void)xb_add(&bar[XB_XCNT(b.x)], 1u);
    return b;
}
__device__ __forceinline__ void xcd_barrier_complete(unsigned* bar, unsigned x, unsigned& nloc, unsigned& nx) {
    const unsigned G = gridDim.x * gridDim.y * gridDim.z;
    unsigned sum, cnt, mine, sp = 0u;
    for (;;) {
        sum = 0u; cnt = 0u; mine = 0u;
#pragma unroll
        for (unsigned j = 0; j < 16; ++j) { const unsigned c = xb_ld(&bar[XB_XCNT(j)]); sum += c; cnt += (c > 0u) ? 1u : 0u; mine = (j == x) ? c : mine; }
        if (sum == G) break;
        __builtin_amdgcn_s_sleep(1);
        if ((++sp & 255u) == 0u) { if (xb_ld(&bar[XB_TMO])) break; if (sp > XB_SPIN_CAP) { atomicAdd(&bar[XB_TMO], 1u); break; } }
    }
    nloc = mine > 0u ? mine : 1u; nx = cnt > 0u ? cnt : 1u;
}

__device__ __forceinline__ void xcd_barrier(const XcdBarrier& b) {
    asm volatile("s_waitcnt vmcnt(0)" ::: "memory");
    __syncthreads();
    if (threadIdx.x == 0) {
        unsigned* bar = b.bar;
        __builtin_amdgcn_s_waitcnt(0);
        unsigned nloc = b.st[0], nx = b.st[1];
        if (nloc == 0u) { xcd_barrier_complete(bar, b.x, nloc, nx); b.st[0] = nloc; b.st[1] = nx; }
        const unsigned old = xb_add(&bar[XB_XSUB(b.x)], 1u);
        const unsigned gen = old / nloc;
        if (old + 1u == (gen + 1u) * nloc) {
            __builtin_amdgcn_fence(__ATOMIC_RELEASE, "agent");
            asm volatile("s_waitcnt vmcnt(0)" ::: "memory");
            const unsigned og = xb_add(&bar[XB_TOP], 1u);
            const unsigned tg = og / nx;
            if (og + 1u == (tg + 1u) * nx) xb_add(&bar[XB_TOPGEN], 1u);
            else XB_SPIN(xb_ld(&bar[XB_TOPGEN]) == tg, bar);
            __builtin_amdgcn_fence(__ATOMIC_ACQUIRE, "agent");
            xb_add(&bar[XB_XGEN(b.x)], 1u);
            asm volatile("s_waitcnt vmcnt(0)" ::: "memory");
        } else {
            XB_SPIN(xb_ld(&bar[XB_XGEN(b.x)]) == gen, bar);
            __builtin_amdgcn_fence(__ATOMIC_ACQUIRE, "agent");
            asm volatile("s_waitcnt vmcnt(0)" ::: "memory");
        }
    }
    __syncthreads();
}

DI int next_item(unsigned char* lds, unsigned* ctr) {
    unsigned* MISC = (unsigned*)(lds + LDS_MISC);
    __syncthreads();
    if (opaque_tid() == 0) { MISC[0] = atomicAdd(ctr, 1u); MISC[1] = 0u; }
    __syncthreads();
    return (int)MISC[0];
}

__global__ void __launch_bounds__(512, 2) mega_fwd(Params p) {
    extern __shared__ __attribute__((aligned(16))) unsigned char lds[];
    cg::grid_group grid = cg::this_grid();
    const int tid = opaque_tid(), lane = tid & 63, wave = __builtin_amdgcn_readfirstlane(tid >> 6);
    PG8_LAS unsigned char* lds3 = (PG8_LAS unsigned char*)lds;
    const Params& p0 = p;
    if (p0.ph_lo < 0) grid.sync();
    volatile LAS unsigned* bst = (volatile LAS unsigned*)(lds3 + LDS_BST);
    if (threadIdx.x == 0) { bst[0] = 0u; bst[1] = 0u; }
    __syncthreads();
    const XcdBarrier gbar = xcd_barrier_post((unsigned*)(p0.ws + WS_CTL) + CW_BAR, bst);
#define GSYNC() xcd_barrier(gbar)
    for (int xs = 0; xs < EXTRA_SYNCS; ++xs) GSYNC();
    for (int ph = p0.ph_lo; ph < p0.ph_hi; ++ph) {
        if ((ph & 7) == 5 || ph == 8) continue;
        if (ph > p0.ph_lo) GSYNC();
        Params p = p0;
        { unsigned char* w_ = p0.ws; asm volatile("" : "+s"(w_)); p.ws = (unsigned char*)(__attribute__((address_space(1))) unsigned char*)w_; }
        unsigned char* ws = p.ws;
        bf16_t* XB = (bf16_t*)(ws + WS_XB);
        unsigned* ctr = (unsigned*)(ws + WS_CTL);
        const int l = ph >> 3, k = ph & 7;
        const float* xin = (l == 0) ? p.x : p.out;
        const int nrep = ((REP_MASK >> k) & 1) ? 2 : 1;
        for (int rep = 0; rep < nrep; ++rep) {
        if (rep > 0) GSYNC();
        if (k == 0 && (PH_MASK & 1)) {
            if (l == 0) prologue_weights(p, lds);
            norm_rows(xin, XB, (float*)(ws + WS_RSS));
        } else if (k == 1 && (PH_MASK & 2)) {
#if !defined(SKIP_G1A)
            const bf16_t* XA = (l == 0) ? XB : (const bf16_t*)p.out;
            { pg8::Gemm g{XA, (const bf16_t*)(ws + WS_W1A) + (size_t)l * N1A * DM, MTOK, N1A, DM}; pg8::StaticOrder S; S.init(MTOK, N1A, gridDim.x, blockIdx.x);
              EpiQK E{(bf16_t*)(ws + WS_QK), (float*)(ws + WS_IW), (const float*)(ws + WS_CS), p.qg + l * 192, p.kg + l * 192, (const float*)(ws + WS_RSS) + (size_t)(2 * l) * MTOK};
              pg8::gemm_phase<EpiQK, pg8::StaticOrder, true, true>(lds3, g, S, E); }
#endif
#if !defined(SKIP_G1B)
            { pg8::Gemm g{(const bf16_t*)(ws + WS_W1B) + (size_t)l * DM * DM, XA, DM, MTOK, DM}; pg8::StaticOrder S; S.init(DM, MTOK, gridDim.x, blockIdx.x);
              EpiVT E{(bf16_t*)(ws + WS_VT), MTOK, (const float*)(ws + WS_RSS) + (size_t)(2 * l) * MTOK};
              pg8::gemm_phase<EpiVT, pg8::StaticOrder, true, true>(lds3, g, S, E); }
#endif
        } else if (k == 2 && (PH_MASK & 4)) {
            for (;;) {
                const int it = next_item(lds, ctr + 16 * (2 * l) + 64 * rep);
                if (it >= 512 + 1024 + 128) break;
                if (it < 512) {
#if !defined(SKIP_DIFF)
                    if (!(REP_SKIP_DIFF && rep > 0)) diff_unit(p, lds, l, (it & 31) >> 2, it & 3, 15 - (it >> 5));
#endif
                } else if (it < 1536) {
#if !defined(SKIP_SEL)
                    const int s = it - 512; select_unit(p, lds, s & 7, 32 * (127 - (s >> 3)));
#endif
                } else { const int s = it - 1536;
                    for (int hh = 0; hh < 4; ++hh) { __syncthreads(); kmean_unit(p, lds, l, s >> 4, hh, s & 15); } }
            }
        } else if (k == 3 && (PH_MASK & 8)) {
            for (;;) {
                const int it = next_item(lds, ctr + 16 * (2 * l + 1) + 64 * rep);
                if (it >= 1024) break;
                const int c = 15 - (it >> 6), bh = it & 31;
                if (((it >> 5) & 1) == 0) dsa_unit(p, lds, bh >> 2, bh & 3, c); else moba_unit(p, lds, l, bh >> 2, bh & 3, c);
            }
        } else if (k == 4 && (PH_MASK & 16)) {
            pg8::Gemm g{(const bf16_t*)p.out + (size_t)MTOK * DM, (const bf16_t*)(ws + WS_WO) + (size_t)l * DM * DM, MTOK, DM, DM};     pg8::StaticOrder S; S.init(MTOK, DM, gridDim.x, blockIdx.x);
            EpiRes E{nullptr, (l == 0) ? (const bf16_t*)XB : (const bf16_t*)p.out, nullptr, (bf16_t*)(ws + WS_SCR), (float*)(ws + WS_RSS) + (size_t)(2 * l + 1) * MTOK};
            pg8::gemm_phase<EpiRes, pg8::StaticOrder, true, true>(lds3, g, S, E);
        } else if (k == 5 && (PH_MASK & 32)) {
        } else if (k == 6 && (PH_MASK & 64)) {
            pg8::Gemm g{(const bf16_t*)(ws + WS_SCR), (const bf16_t*)(ws + WS_W3) + (size_t)l * 2 * DFF * DM, MTOK, 2 * DFF, DM}; pg8::StaticOrder S; S.init(MTOK, 2 * DFF, gridDim.x, blockIdx.x);
            EpiSwi E{(bf16_t*)(ws + WS_H), (const float*)(ws + WS_RSS) + (size_t)(2 * l + 1) * MTOK};
            pg8::gemm_phase<EpiSwi, pg8::StaticOrder, true, true>(lds3, g, S, E);
        } else if (PH_MASK & 128) {
            pg8::Gemm g{(const bf16_t*)(ws + WS_H), (const bf16_t*)(ws + WS_WD) + (size_t)l * DM * DFF, MTOK, DM, DFF}; pg8::StaticOrder S; S.init(MTOK, DM, gridDim.x, blockIdx.x);
            EpiRes E{nullptr, (const bf16_t*)(ws + WS_SCR), (l == 0) ? nullptr : p.out, (l == 0) ? (bf16_t*)p.out : nullptr, (l == 0) ? (float*)(ws + WS_RSS) + (size_t)2 * MTOK : nullptr};
            pg8::gemm_phase<EpiRes, pg8::StaticOrder, true, true>(lds3, g, S, E);
        }
        }
    }
}

#ifndef ONE_LAUNCH_X
#define ONE_LAUNCH 1
#endif
extern "C" void kernel_launch(void* const* d_in, const int* in_sizes, int n_in, void* d_out, int out_size, void* d_ws, size_t ws_size, hipStream_t stream) {
    static int grid = 0;
    if (grid == 0) {
        if (n_in != 12 || ws_size < WS_END) { fprintf(stderr, "kernel_launch: unexpected n_in %d / ws %zu\n", n_in, ws_size); grid = -1; return; }
        int dev = 0, cus = 0, per_cu = 0;
        hipGetDevice(&dev); hipDeviceGetAttribute(&cus, hipDeviceAttributeMultiprocessorCount, dev);
        if (hipFuncSetAttribute((const void*)mega_fwd, hipFuncAttributeMaxDynamicSharedMemorySize, LDS_BYTES) != hipSuccess) { fprintf(stderr, "hipFuncSetAttribute failed\n"); grid = -1; return; }
        hipOccupancyMaxActiveBlocksPerMultiprocessor(&per_cu, (const void*)mega_fwd, 512, LDS_BYTES);
        (void)hipGetLastError();
        if (per_cu < 1) per_cu = 1;
        grid = cus * per_cu; if (grid > 256) grid = 256;
    }
    if (grid < 0) return;
    hipMemsetAsync((char*)d_ws + WS_CTL, 0, CTL_BYTES, stream);
    Params p{};
    p.x = (const float*)d_in[0]; p.attn_g = (const float*)d_in[1]; p.w_in = (const float*)d_in[2]; p.qg = (const float*)d_in[3]; p.kg = (const float*)d_in[4];
    p.dlam = (const float*)d_in[5]; p.subln = (const float*)d_in[6]; p.w_out = (const float*)d_in[7]; p.ffn_g = (const float*)d_in[8];
    p.w_gate = (const float*)d_in[9]; p.w_up = (const float*)d_in[10]; p.w_down = (const float*)d_in[11];
    p.out = (float*)d_out; p.ws = (unsigned char*)d_ws;
#if ONE_LAUNCH
    p.ph_lo = 0; p.ph_hi = 16;
    void* args[] = {&p};
    hipError_t e = hipLaunchCooperativeKernel((const void*)mega_fwd, dim3(grid), dim3(512), args, LDS_BYTES, stream);
    if (e != hipSuccess) fprintf(stderr, "cooperative launch failed: %s (grid %d)\n", hipGetErrorString(e), grid);
#else
    for (int ph = 0; ph < 16; ++ph) {
        p.ph_lo = ph; p.ph_hi = ph + 1;
        hipLaunchKernelGGL(mega_fwd, dim3(grid), dim3(512), LDS_BYTES, stream, p);
    }
#endif
}
```

```cpp
#include <hip/hip_runtime.h>
#include <hip/hip_cooperative_groups.h>
#include <cstdio>
#include <cstdint>
#include <cmath>
namespace cg = cooperative_groups;

namespace pg8 {
#define PG8_LAS __attribute__((address_space(3)))
typedef unsigned short bf16_t;
typedef short bf16x8 __attribute__((ext_vector_type(8)));
typedef float f32x4 __attribute__((ext_vector_type(4)));
typedef unsigned u32x4 __attribute__((ext_vector_type(4)));
constexpr int BM = 256, BK = 64, HALF = 128, HTB = HALF * BK * 2  , STAGE_BYTES = 8 * HTB, NXCD = 8, WGM = 8;

__host__ __device__ __forceinline__ int lds_byte(int r, int c) { const int st = (r >> 4) * 2 + (c >> 5), rr = r & 15, cc = c & 31, ob = rr * 64 + cc * 2; return st * 1024 + (ob ^ (((ob >> 9) & 1) << 5)); }
__host__ __device__ __forceinline__ void stage_rc(int b, int& R, int& C) { const int st = b / 1024, sb = b % 1024, swz = sb ^ (((sb >> 9) & 1) << 5); R = (st >> 1) * 16 + swz / 64; C = (st & 1) * 32 + (swz % 64) / 2; }
__host__ __device__ __forceinline__ int perm32(int rho) { const int n = rho >> 4, i = rho & 15; return 8 * (i >> 2) + 4 * n + (i & 3); }

struct Unit { int pm, pn; };
struct Gemm { const bf16_t* A; const bf16_t* Bt; int M, N, K; };

struct StaticOrder {
    int nM, nN, nwg, G, c;
    __host__ __device__ void init(int M, int N, int G_, int c_) { nM = M / BM; nN = N / BM; nwg = nM * nN; G = G_; c = c_; }
    __host__ __device__ bool next(int i, Unit& u) const {
        const long L = (long)i * G + c; if (L >= nwg) return false;
        int wgid = (int)L; { const int q = nwg / NXCD, r = nwg % NXCD, xcd = wgid % NXCD, off = wgid / NXCD; wgid = (xcd < r ? xcd * (q + 1) : r * (q + 1) + (xcd - r) * q) + off; }
        const int nig = WGM * nN, gid = wgid / nig, fm = gid * WGM, gsz = (nM - fm) < WGM ? (nM - fm) : WGM;
        u.pm = fm + ((wgid % nig) % gsz); u.pn = (wgid % nig) / gsz; return true;
    }
    __device__ __forceinline__ void a_ready(const Unit&) const {}
    __device__ __forceinline__ void done(const Unit&) const {}
};

__device__ __forceinline__ unsigned cvt_pk_bf16(float lo, float hi) { unsigned r; asm volatile("v_cvt_pk_bf16_f32 %0, %1, %2" : "=v"(r) : "v"(lo), "v"(hi)); return r; }
typedef float f32x2 __attribute__((ext_vector_type(2)));
template <class Epi, class Sched, bool ALIGN_EPI = false, bool SP2 = false>
__device__ __forceinline__ void gemm_phase(PG8_LAS unsigned char* lds, const Gemm g, const Sched& S, const Epi& E) {
    int tid_ = threadIdx.x; asm volatile("" : "+v"(tid_) :: "memory");
    const int tid = tid_, wid = __builtin_amdgcn_readfirstlane(tid >> 6), lane = tid & 63, wr = wid >> 2, wc = wid & 3, fr = lane & 15, fq = lane >> 4;
    const int K = g.K, nt = K / BK;
    unsigned voffA[2], voffB[2];
#pragma unroll
    for (int i = 0; i < 2; ++i) { int R, C; stage_rc(tid * 16 + i * 8192, R, C); const int Rb = Epi::PERM ? ((R & ~31) + perm32(R & 31)) : R;
        voffA[i] = (unsigned)(R * K + C) * 2u; voffB[i] = (unsigned)(Rb * K + C) * 2u; }
    const size_t kstep = (size_t)(BK * 2);
    const size_t hstep = (size_t)HALF * K * 2;
    const size_t tstep = 2 * hstep;
    const unsigned ldsw = (unsigned)wid * 1024u;
    const int aoff = lds_byte(wr * 64 + fr, fq * 8), boff = lds_byte(wc * 32 + fr, fq * 8);
#define PG8_SA(b, h) (((b) * 2 + (h)) * HTB)
#define PG8_SB(b, h) ((4 + (b) * 2 + (h)) * HTB)
#define PG8_STAGE(bufoff, gbase, voff) do { _Pragma("unroll") for (int _i = 0; _i < 2; ++_i) \
        __builtin_amdgcn_global_load_lds((const unsigned*)((const char*)(gbase) + (voff)[_i]), (PG8_LAS unsigned*)(lds + (bufoff) + ldsw + _i * 8192), 16, 0, 0); } while (0)
#define PG8_LDA(dst, b, h) do { _Pragma("unroll") for (int m = 0; m < 4; ++m) _Pragma("unroll") for (int k = 0; k < 2; ++k) dst[m][k] = *(const PG8_LAS bf16x8*)(lds + PG8_SA(b, h) + aoff + m * 2048 + k * 1024); } while (0)
#define PG8_LDB(dst, b, h) do { _Pragma("unroll") for (int n = 0; n < 2; ++n) _Pragma("unroll") for (int k = 0; k < 2; ++k) dst[n][k] = *(const PG8_LAS bf16x8*)(lds + PG8_SB(b, h) + boff + n * 2048 + k * 1024); } while (0)
#define PG8_MMA(ai, bj, At, Bt) do { __builtin_amdgcn_s_setprio(1); _Pragma("unroll") for (int m = 0; m < 4; ++m) _Pragma("unroll") for (int n = 0; n < 2; ++n) _Pragma("unroll") for (int k = 0; k < 2; ++k) \
        acc[ai][bj][m][n] = __builtin_amdgcn_mfma_f32_16x16x32_bf16(Bt[n][k], At[m][k], acc[ai][bj][m][n], 0, 0, 0); __builtin_amdgcn_s_setprio(0); } while (0)
#define PG8_WAIT_V(n) asm volatile("s_waitcnt vmcnt(" #n ")" ::: "memory")
#define PG8_WAIT_L(n) asm volatile("s_waitcnt lgkmcnt(" #n ")" ::: "memory")
#define PG8_BAR __builtin_amdgcn_s_barrier()
#define PG8_SCHED __builtin_amdgcn_sched_barrier(0)
    Unit cur, nxt; int ui = 0;
    if (!S.next(0, cur)) return;
    f32x4 acc[2][2][4][2];
#pragma unroll
    for (int a = 0; a < 2; ++a)
#pragma unroll
        for (int b = 0; b < 2; ++b)
#pragma unroll
            for (int m = 0; m < 4; ++m)
#pragma unroll
                for (int n = 0; n < 2; ++n) acc[a][b][m][n] = (f32x4){0.f, 0.f, 0.f, 0.f};
    bf16x8 At[4][2], B0[2][2], B1[2][2];
    const char* cA = (const char*)g.A + (size_t)cur.pm * tstep; const char* cB = (const char*)g.Bt + (size_t)cur.pn * tstep;
    S.a_ready(cur);
    if constexpr (SP2) {
        PG8_STAGE(PG8_SB(0, 0), cB, voffB); PG8_STAGE(PG8_SB(0, 1), cB + hstep, voffB); PG8_STAGE(PG8_SA(0, 0), cA, voffA); PG8_STAGE(PG8_SA(0, 1), cA + hstep, voffA);
        if (wr == 1) PG8_BAR;
        PG8_WAIT_V(2); PG8_BAR;
        PG8_STAGE(PG8_SB(1, 0), cB + kstep, voffB); PG8_STAGE(PG8_SA(1, 0), cA + kstep, voffA); PG8_STAGE(PG8_SB(1, 1), cB + hstep + kstep, voffB);
        PG8_WAIT_V(6); PG8_BAR;
    } else {
        PG8_STAGE(PG8_SB(0, 0), cB, voffB); PG8_STAGE(PG8_SA(0, 0), cA, voffA); PG8_STAGE(PG8_SB(0, 1), cB + hstep, voffB); PG8_STAGE(PG8_SA(0, 1), cA + hstep, voffA);
        if (wr == 1) PG8_BAR;
        PG8_WAIT_V(4); PG8_BAR;
        PG8_STAGE(PG8_SB(1, 0), cB + kstep, voffB); PG8_STAGE(PG8_SA(1, 0), cA + kstep, voffA); PG8_STAGE(PG8_SB(1, 1), cB + hstep + kstep, voffB);
        PG8_WAIT_V(6); PG8_BAR;
    }
    for (;;) {
        const bool has_next = S.next(ui + 1, nxt);
        const char* nA = has_next ? (const char*)g.A + (size_t)nxt.pm * tstep : cA; const char* nB = has_next ? (const char*)g.Bt + (size_t)nxt.pn * tstep : cB;
        for (int t = 0; t < nt; t += 2) {
            const bool last = (t == nt - 2);
            const char* a1 = cA + (size_t)(t + 1) * kstep;
            const char* a2 = last ? nA : cA + (size_t)(t + 2) * kstep; const char* b2 = last ? nB : cB + (size_t)(t + 2) * kstep;
            const char* a3 = a2 + kstep; const char* b3 = b2 + kstep;
            if (last && has_next) S.a_ready(nxt);
            if constexpr (SP2) {
            PG8_LDB(B0, 0, 0); PG8_LDB(B1, 0, 1); PG8_SCHED; PG8_LDA(At, 0, 0); PG8_STAGE(PG8_SA(1, 1), a1 + hstep, voffA);
            PG8_WAIT_V(8); PG8_WAIT_L(0); PG8_BAR; PG8_MMA(0, 0, At, B0); PG8_MMA(0, 1, At, B1); PG8_BAR; PG8_SCHED;
            PG8_LDA(At, 0, 1); PG8_STAGE(PG8_SB(0, 0), b2, voffB); PG8_STAGE(PG8_SB(0, 1), b2 + hstep, voffB); PG8_STAGE(PG8_SA(0, 0), a2, voffA);
            PG8_WAIT_V(8); PG8_WAIT_L(0); PG8_BAR; PG8_MMA(1, 0, At, B0); PG8_MMA(1, 1, At, B1); PG8_BAR; PG8_SCHED;
            PG8_LDB(B0, 1, 0); PG8_LDB(B1, 1, 1); PG8_SCHED; PG8_LDA(At, 1, 0); PG8_STAGE(PG8_SA(0, 1), a2 + hstep, voffA);
            PG8_WAIT_V(8); PG8_WAIT_L(0); PG8_BAR; PG8_MMA(0, 0, At, B0); PG8_MMA(0, 1, At, B1); PG8_BAR; PG8_SCHED;
            PG8_LDA(At, 1, 1); PG8_STAGE(PG8_SB(1, 0), b3, voffB); PG8_STAGE(PG8_SB(1, 1), b3 + hstep, voffB); PG8_STAGE(PG8_SA(1, 0), a3, voffA);
            PG8_WAIT_V(8); PG8_WAIT_L(0); PG8_BAR; PG8_MMA(1, 0, At, B0); PG8_MMA(1, 1, At, B1); PG8_BAR; PG8_SCHED;
            } else {
            PG8_LDB(B0, 0, 0); PG8_SCHED; PG8_LDA(At, 0, 0); PG8_STAGE(PG8_SA(1, 1), a1 + hstep, voffA);
            PG8_WAIT_L(8); PG8_BAR; PG8_WAIT_L(0); PG8_MMA(0, 0, At, B0); PG8_BAR; PG8_SCHED;
            PG8_LDB(B1, 0, 1); PG8_STAGE(PG8_SB(0, 0), b2, voffB);
            PG8_BAR; PG8_WAIT_L(0); PG8_MMA(0, 1, At, B1); PG8_BAR;
            PG8_LDA(At, 0, 1); PG8_STAGE(PG8_SA(0, 0), a2, voffA);
            PG8_BAR; PG8_WAIT_L(0); PG8_MMA(1, 0, At, B0); PG8_BAR; PG8_SCHED;
            PG8_STAGE(PG8_SB(0, 1), b2 + hstep, voffB);
            PG8_WAIT_V(6); PG8_BAR; PG8_MMA(1, 1, At, B1); PG8_BAR;
            PG8_LDB(B0, 1, 0); PG8_SCHED; PG8_LDA(At, 1, 0); PG8_STAGE(PG8_SA(0, 1), a2 + hstep, voffA);
            PG8_WAIT_L(8); PG8_BAR; PG8_WAIT_L(0); PG8_MMA(0, 0, At, B0); PG8_BAR; PG8_SCHED;
            PG8_LDB(B1, 1, 1); PG8_STAGE(PG8_SB(1, 0), b3, voffB);
            PG8_BAR; PG8_WAIT_L(0); PG8_MMA(0, 1, At, B1); PG8_BAR;
            PG8_LDA(At, 1, 1); PG8_STAGE(PG8_SA(1, 0), a3, voffA);
            PG8_BAR; PG8_WAIT_L(0); PG8_MMA(1, 0, At, B0); PG8_BAR; PG8_SCHED;
            PG8_STAGE(PG8_SB(1, 1), b3 + hstep, voffB);
            PG8_WAIT_V(6); PG8_BAR; PG8_MMA(1, 1, At, B1); PG8_BAR;
            }
        }
        if constexpr (ALIGN_EPI) { if (wr == 0) PG8_BAR; }
        if constexpr (!Epi::AFTER_DRAIN) { E(acc, cur, wr, wc, fr, fq); S.done(cur); }
        if (!has_next) break;
#pragma unroll
        for (int a = 0; a < 2; ++a)
#pragma unroll
            for (int b = 0; b < 2; ++b)
#pragma unroll
                for (int m = 0; m < 4; ++m)
#pragma unroll
                    for (int n = 0; n < 2; ++n) acc[a][b][m][n] = (f32x4){0.f, 0.f, 0.f, 0.f};
        cur = nxt; cA = nA; cB = nB; ++ui;
        if constexpr (ALIGN_EPI) { if (wr == 1) PG8_BAR; }
    }
    PG8_WAIT_V(0);
    if constexpr (!ALIGN_EPI) { if (wr == 0) PG8_BAR; }
    PG8_BAR;
    if constexpr (Epi::AFTER_DRAIN) { E.fused(acc, cur, wr, wc, fr, fq, lds, wid, lane); S.done(cur); }
#undef PG8_SA
#undef PG8_SB
#undef PG8_STAGE
#undef PG8_LDA
#undef PG8_LDB
#undef PG8_MMA
#undef PG8_WAIT_V
#undef PG8_WAIT_L
#undef PG8_BAR
#undef PG8_SCHED
}
}

#ifndef PH_MASK
#define PH_MASK 255
#endif
#ifndef REP_SKIP_DIFF
#define REP_SKIP_DIFF 1
#endif
#ifndef SEL_REP_SCORE
#define SEL_REP_SCORE 1
#endif
#ifndef SEL_REP_ROWS
#define SEL_REP_ROWS 1
#endif
#ifndef EXTRA_SYNCS
#define EXTRA_SYNCS 0
#endif
#ifndef PROBE_XATOM
#define PROBE_XATOM 0
#endif
#ifndef REP_MASK
#define REP_MASK 0
#endif
#ifndef ONE_LAUNCH
#define ONE_LAUNCH 1
#endif
typedef unsigned short bf16_t;
typedef short bf16x8 __attribute__((ext_vector_type(8)));
typedef short s16x4 __attribute__((ext_vector_type(4)));
typedef float f32x4 __attribute__((ext_vector_type(4)));
typedef float f32x16 __attribute__((ext_vector_type(16)));
typedef unsigned u32x4 __attribute__((ext_vector_type(4)));
typedef unsigned u32x2 __attribute__((ext_vector_type(2)));
typedef __bf16 bf16x2_t __attribute__((ext_vector_type(2)));
typedef float f32x2_t __attribute__((ext_vector_type(2)));
typedef unsigned long long u64;
#define DI __device__ __forceinline__
#define LAS __attribute__((address_space(3)))
#define GAS __attribute__((address_space(1)))
#define MFMA32(a, b, c) __builtin_amdgcn_mfma_f32_32x32x16_bf16((a), (b), (c), 0, 0, 0)
#define NEG_INF (-__builtin_inff())

constexpr int SEQ = 4096, BATCH = 8, DM = 1024, MTOK = BATCH * SEQ, DFF = 2816, INC = 3656;
constexpr int N1A = 2816;
constexpr int NSLOT = 41;
constexpr float EPS = 1e-6f;
constexpr size_t MiB = 1u << 20;
constexpr size_t WS_CTL = 0, CTL_BYTES = 1 * MiB;
constexpr int CW_BAR = 4096;
constexpr size_t WS_KMEAN = 65536;
constexpr size_t WS_RSS = 512 * 1024;
constexpr size_t WS_CS = 1 * MiB;
constexpr size_t WS_IW = 2 * MiB;
constexpr size_t WS_W1A = 4 * MiB, WS_W1B = 15 * MiB, WS_WO = 19 * MiB, WS_W3 = 23 * MiB, WS_WD = 45 * MiB;
constexpr size_t WS_BM = 56 * MiB;
constexpr size_t WS_XB = 72 * MiB;
constexpr size_t WS_QK = 136 * MiB;
constexpr size_t WS_VT = 300 * MiB;
constexpr size_t WS_H = 136 * MiB;
constexpr size_t WS_SCR = 364 * MiB;
constexpr size_t WS_END = 492 * MiB;
constexpr int LDS_BYTES = 147456;

DI unsigned pk2(float lo, float hi) { f32x2_t v = {lo, hi}; bf16x2_t b = __builtin_convertvector(v, bf16x2_t); return __builtin_bit_cast(unsigned, b); }
DI float bf_lo(unsigned u) { return __builtin_bit_cast(float, u << 16); }
DI float bf_hi(unsigned u) { return __builtin_bit_cast(float, u & 0xffff0000u); }
DI int opaque_tid() { int t = threadIdx.x; asm volatile("" : "+v"(t)); return t; }
template <class T> DI T* gp(T* p) { return (T*)(__attribute__((address_space(1))) T*)p; }
DI int crow(int r, int h) { return (r & 3) + 8 * (r >> 2) + 4 * h; }
DI float shx(float v, int m, int lane) { return __builtin_bit_cast(float, __builtin_amdgcn_ds_bpermute((lane ^ m) << 2, __builtin_bit_cast(int, v))); }
DI float wave_sum(float v, int lane) {
#pragma unroll
    for (int o = 1; o < 64; o <<= 1) v += shx(v, o, lane);
    return v;
}

struct Params {
    const float* x; const float* attn_g; const float* w_in; const float* qg; const float* kg; const float* dlam; const float* subln;
    const float* w_out; const float* ffn_g; const float* w_gate; const float* w_up; const float* w_down;
    float* out; unsigned char* ws;
    int ph_lo, ph_hi;
};

struct EpiQK {
    static constexpr bool PERM = true, AFTER_DRAIN = false;
    bf16_t* QK; float* iw; const float* cs; const float* qg; const float* kg; const float* rss;
    DI void head(const pg8::f32x4 (&acc)[2][2][4][2], int row0, int fq, int lane, const float* g, bf16_t* dst) const {
        const bool norm = (g != nullptr);
        f32x4 g00 = {1.f, 1.f, 1.f, 1.f}, g01 = g00, g10 = g00, g11 = g00;
        if (norm) { g00 = *(const f32x4*)(g + 8 * fq); g01 = *(const f32x4*)(g + 8 * fq + 4); g10 = *(const f32x4*)(g + 32 + 8 * fq); g11 = *(const f32x4*)(g + 32 + 8 * fq + 4); }
        f32x4 nc0, nc1, ns0, ns1; float nrs;
        { const int row = row0, pos = row & (SEQ - 1); const float* cp = cs + (size_t)pos * 64 + 8 * fq;
          nc0 = *(const f32x4*)(cp); nc1 = *(const f32x4*)(cp + 4); ns0 = *(const f32x4*)(cp + 32); ns1 = *(const f32x4*)(cp + 36); nrs = rss[row]; }
#pragma unroll
        for (int idx = 0; idx < 8; ++idx) {
                const int ai = idx >> 2, m = idx & 3;
                const int row = row0 + ai * 128 + m * 16;
                const f32x4 c0 = nc0, c1 = nc1, s0 = ns0, s1 = ns1; const float rsv = nrs;
                if (idx < 7) { const int nrow = row0 + ((idx + 1) >> 2) * 128 + ((idx + 1) & 3) * 16, npos = nrow & (SEQ - 1); const float* cp = cs + (size_t)npos * 64 + 8 * fq;
                    nc0 = *(const f32x4*)(cp); nc1 = *(const f32x4*)(cp + 4); ns0 = *(const f32x4*)(cp + 32); ns1 = *(const f32x4*)(cp + 36); nrs = rss[nrow]; }
                const float rr = rsqrtf(rsv * (1.f / DM) + EPS);
                f32x4 a00 = acc[ai][0][m][0] * rr, a01 = acc[ai][0][m][1] * rr, a10 = acc[ai][1][m][0] * rr, a11 = acc[ai][1][m][1] * rr;
                {
                    f32x4 sq = a00 * a00 + a01 * a01 + a10 * a10 + a11 * a11;
                    float ss = (sq[0] + sq[1]) + (sq[2] + sq[3]);
                    ss += shx(ss, 16, lane); ss += shx(ss, 32, lane);
                    const float rn = norm ? rsqrtf(ss * (1.f / 64.f) + EPS) : 1.f;
                    a00 = a00 * rn * g00; a01 = a01 * rn * g01; a10 = a10 * rn * g10; a11 = a11 * rn * g11;
                }
                const f32x4 o00 = a00 * c0 - a10 * s0, o01 = a01 * c1 - a11 * s1, o10 = a00 * s0 + a10 * c0, o11 = a01 * s1 + a11 * c1;
                u32x4 w0, w1;
                w0[0] = pk2(o00[0], o00[1]); w0[1] = pk2(o00[2], o00[3]); w0[2] = pk2(o01[0], o01[1]); w0[3] = pk2(o01[2], o01[3]);
                w1[0] = pk2(o10[0], o10[1]); w1[1] = pk2(o10[2], o10[3]); w1[2] = pk2(o11[0], o11[1]); w1[3] = pk2(o11[2], o11[3]);
                bf16_t* dp = dst + (size_t)row * 64 + 8 * fq;
                *(u32x4*)dp = w0; *(u32x4*)(dp + 32) = w1;
                __builtin_amdgcn_sched_barrier(0);
        }
    }
    DI void operator()(const pg8::f32x4 (&acc)[2][2][4][2], const pg8::Unit& u, int wr, int wc, int fr, int fq) const {
        const int T = u.pn, row0 = u.pm * 256 + wr * 64 + fr;
        if (T == 10 && wc == 1) {
            if (fq == 0) {
#pragma unroll
                for (int ai = 0; ai < 2; ++ai)
#pragma unroll
                    for (int m = 0; m < 4; ++m) {
                        const int row = row0 + ai * 128 + m * 16;
                        const float sc = 0.35355339059f * 0.125f * rsqrtf(rss[row] * (1.f / DM) + EPS);
                        f32x4 a = acc[ai][0][m][0], b = acc[ai][0][m][1];
                        *(f32x4*)(iw + (size_t)row * 8) = a * sc; *(f32x4*)(iw + (size_t)row * 8 + 4) = b * sc;
                    }
            }
            return;
        }
        if (T == 10 && wc > 1) return;
        const int slot = (T == 10) ? 40 : T * 4 + wc;
        const float* g = (T == 0) ? qg : (T == 1) ? kg : (T <= 3) ? qg + 64 : (T <= 5) ? kg + 64 : (T == 6) ? qg + 128 : (T == 7) ? kg + 128 : nullptr;
        head(acc, row0, fq, fr + 16 * fq, g, QK + (size_t)slot * MTOK * 64);
    }
};
struct EpiVT {
    static constexpr bool PERM = true, AFTER_DRAIN = false;
    bf16_t* O; int ldc; const float* rss;
    DI void operator()(const pg8::f32x4 (&acc)[2][2][4][2], const pg8::Unit& u, int wr, int wc, int fr, int fq) const {
        const int row0 = u.pm * 256 + wr * 64 + fr, col0 = u.pn * 256 + wc * 32 + 8 * fq;
        f32x4 r0[2], r1[2];
#pragma unroll
        for (int bj = 0; bj < 2; ++bj) { const f32x4 s0 = *(const f32x4*)(rss + col0 + bj * 128), s1 = *(const f32x4*)(rss + col0 + bj * 128 + 4);
#pragma unroll
            for (int e = 0; e < 4; ++e) { r0[bj][e] = rsqrtf(s0[e] * (1.f / DM) + EPS); r1[bj][e] = rsqrtf(s1[e] * (1.f / DM) + EPS); } }
#pragma unroll
        for (int ai = 0; ai < 2; ++ai)
#pragma unroll
            for (int m = 0; m < 4; ++m) {
                bf16_t* rp = O + (size_t)(row0 + ai * 128 + m * 16) * ldc + col0;
#pragma unroll
                for (int bj = 0; bj < 2; ++bj) {
                    const f32x4 v0 = acc[ai][bj][m][0] * r0[bj], v1 = acc[ai][bj][m][1] * r1[bj];
                    u32x4 w; w[0] = pk2(v0[0], v0[1]); w[1] = pk2(v0[2], v0[3]); w[2] = pk2(v1[0], v1[1]); w[3] = pk2(v1[2], v1[3]);
                    *(u32x4*)(rp + bj * 128) = w;
                }
            }
    }
};
struct EpiRes {
    static constexpr bool PERM = true, AFTER_DRAIN = false;
    const float* srcf; const bf16_t* srcb; float* out; bf16_t* xb; float* rss;
    DI void operator()(const pg8::f32x4 (&acc)[2][2][4][2], const pg8::Unit& u, int wr, int wc, int fr, int fq) const {
        const int row0 = u.pm * 256 + wr * 64 + fr, col0 = u.pn * 256 + wc * 32 + 8 * fq, lane = fr + 16 * fq;
#pragma unroll
        for (int ai = 0; ai < 2; ++ai)
#pragma unroll
            for (int m = 0; m < 4; ++m) {
                const int row = row0 + ai * 128 + m * 16;
                const size_t off = (size_t)row * DM + col0;
                float ss = 0.f;
#pragma unroll
                for (int bj = 0; bj < 2; ++bj) {
                    f32x4 x0, x1;
                    if (srcb) { const u32x4 w = *(const u32x4*)(srcb + off + bj * 128);
                        x0 = (f32x4){bf_lo(w[0]), bf_hi(w[0]), bf_lo(w[1]), bf_hi(w[1])}; x1 = (f32x4){bf_lo(w[2]), bf_hi(w[2]), bf_lo(w[3]), bf_hi(w[3])}; }
                    else { x0 = *(const f32x4*)(srcf + off + bj * 128); x1 = *(const f32x4*)(srcf + off + bj * 128 + 4); }
                    x0 = x0 + acc[ai][bj][m][0]; x1 = x1 + acc[ai][bj][m][1];
                    if (out) { *(f32x4*)(out + off + bj * 128) = x0; *(f32x4*)(out + off + bj * 128 + 4) = x1; }
                    if (xb) { u32x4 w; w[0] = pk2(x0[0], x0[1]); w[1] = pk2(x0[2], x0[3]); w[2] = pk2(x1[0], x1[1]); w[3] = pk2(x1[2], x1[3]); *(u32x4*)(xb + off + bj * 128) = w; }
                    const f32x4 sq = x0 * x0 + x1 * x1; ss += (sq[0] + sq[1]) + (sq[2] + sq[3]);
                }
                if (rss) { ss += shx(ss, 16, lane); ss += shx(ss, 32, lane); if (fq == 0) atomicAdd(rss + row, ss); }
            }
    }
};
struct EpiSwi {
    static constexpr bool PERM = true, AFTER_DRAIN = false;
    bf16_t* H; const float* rss;
    DI void operator()(const pg8::f32x4 (&acc)[2][2][4][2], const pg8::Unit& u, int wr, int wc, int fr, int fq) const {
        const int row0 = u.pm * 256 + wr * 64 + fr, col0 = u.pn * 128 + wc * 32 + 8 * fq;
        float rsv[8];
#pragma unroll
        for (int e = 0; e < 8; ++e) rsv[e] = rss[row0 + (e >> 2) * 128 + (e & 3) * 16];
#pragma unroll
        for (int ai = 0; ai < 2; ++ai)
#pragma unroll
            for (int m = 0; m < 4; ++m) {
                float hv[8];
                const float rr = rsqrtf(rsv[4 * ai + m] * (1.f / DM) + EPS);
#pragma unroll
                for (int n = 0; n < 2; ++n)
#pragma unroll
                    for (int j = 0; j < 4; ++j) {
                        const float g = acc[ai][0][m][n][j] * rr, up = acc[ai][1][m][n][j] * rr;
                        hv[4 * n + j] = g * up * __builtin_amdgcn_rcpf(1.f + __builtin_amdgcn_exp2f(-1.44269504089f * g));
                    }
                u32x4 w; w[0] = pk2(hv[0], hv[1]); w[1] = pk2(hv[2], hv[3]); w[2] = pk2(hv[4], hv[5]); w[3] = pk2(hv[6], hv[7]);
                *(u32x4*)(H + (size_t)(row0 + ai * 128 + m * 16) * DFF + col0) = w;
            }
    }
};

DI void wconv_item(const float* W, int N, int col0, int nvalid, const float* gk, bf16_t* WT, int K, int n0, int k0, LAS float* scr, int lane) {
    const int c = lane & 31;
    const int cc = (c < nvalid) ? c : 0;
    float wv[32], gv[32];
#pragma unroll
    for (int i = 0; i < 32; ++i) { const int kk = 2 * i + (lane >> 5); wv[i] = W[(size_t)(k0 + kk) * N + col0 + cc]; gv[i] = gk ? gk[k0 + kk] : 1.f; }
#pragma unroll
    for (int i = 0; i < 32; ++i) { const int kk = 2 * i + (lane >> 5); scr[kk * 33 + c] = (c < nvalid) ? wv[i] * gv[i] : 0.f; }
    asm volatile("s_waitcnt lgkmcnt(0)" ::: "memory");
    const int ch = lane & 7;
#pragma unroll
    for (int j = 0; j < 4; ++j) {
        const int n = (lane >> 3) + 8 * j; const LAS float* s = scr + (8 * ch) * 33 + n;
        u32x4 o; o[0] = pk2(s[0], s[33]); o[1] = pk2(s[2 * 33], s[3 * 33]); o[2] = pk2(s[4 * 33], s[5 * 33]); o[3] = pk2(s[6 * 33], s[7 * 33]);
        *(u32x4*)(WT + (size_t)(n0 + n) * K + k0 + 8 * ch) = o;
    }
    asm volatile("s_waitcnt lgkmcnt(0)" ::: "memory");
}
DI void map_w1a(int n0, int& col0, int& nvalid) {
    const int T = n0 >> 8, c = n0 & 255, bj = c >> 7, wc = (c >> 5) & 3, d0 = 32 * bj;
    nvalid = 32;
    if (T == 10) { if (wc == 0) col0 = 3584 + d0; else if (wc == 1 && bj == 0) { col0 = 3648; nvalid = 8; } else { col0 = 0; nvalid = 0; } return; }
    const int s = T * 4 + wc;
    int base;
    if (s < 4) base = 0 + 64 * s; else if (s < 8) base = 256 + 64 * (s - 4); else if (s < 16) base = 768 + 64 * (s - 8); else if (s < 24) base = 1280 + 64 * (s - 16);
    else if (s < 28) base = 2304 + 64 * (s - 24); else if (s < 32) base = 2560 + 64 * (s - 28); else base = 3072 + 64 * (s - 32);
    col0 = base + d0;
}
DI void prologue_weights(const Params& p, unsigned char* lds) {
    const int tid = opaque_tid(), lane = tid & 63, wave = __builtin_amdgcn_readfirstlane(tid >> 6);
    LAS float* scr = (LAS float*)((LAS unsigned char*)lds) + wave * (64 * 33);
    const int gw = blockIdx.x * 8 + wave, NGW = gridDim.x * 8;
    constexpr int I1A = 88 * 16, I1B = 32 * 16, IO = 32 * 16, I3 = 176 * 16, ID = 32 * 44, IL = I1A + I1B + IO + I3 + ID;
    unsigned char* ws = p.ws;
    for (int it = gw; it < 2 * IL; it += NGW) {
        const int l = it / IL; int r = it - l * IL;
        if (r < I1A) { const int n0 = (r >> 4) * 32, k0 = (r & 15) * 64; int col0, nv; map_w1a(n0, col0, nv);
            wconv_item(p.w_in + (size_t)l * DM * INC, INC, col0, nv, p.attn_g + l * DM, (bf16_t*)(ws + WS_W1A) + (size_t)l * N1A * DM, DM, n0, k0, scr, lane); continue; }
        r -= I1A;
        if (r < I1B) { const int n0 = (r >> 4) * 32, k0 = (r & 15) * 64;
            const int col0 = n0 < 256 ? 512 + n0 : n0 < 768 ? 1792 + (n0 - 256) : 2816 + (n0 - 768);
            wconv_item(p.w_in + (size_t)l * DM * INC, INC, col0, 32, p.attn_g + l * DM, (bf16_t*)(ws + WS_W1B) + (size_t)l * DM * DM, DM, n0, k0, scr, lane); continue; }
        r -= I1B;
        if (r < IO) { const int n0 = (r >> 4) * 32, k0 = (r & 15) * 64;
            wconv_item(p.w_out + (size_t)l * DM * DM, DM, n0, 32, nullptr, (bf16_t*)(ws + WS_WO) + (size_t)l * DM * DM, DM, n0, k0, scr, lane); continue; }
        r -= IO;
        if (r < I3) { const int n0 = (r >> 4) * 32, k0 = (r & 15) * 64; const int T = n0 >> 8, c = n0 & 255, bj = c >> 7, cc = c & 127;
            const float* W = (bj ? p.w_up : p.w_gate) + (size_t)l * DM * DFF;
            wconv_item(W, DFF, 128 * T + cc, 32, p.ffn_g + l * DM, (bf16_t*)(ws + WS_W3) + (size_t)l * 2 * DFF * DM, DM, n0, k0, scr, lane); continue; }
        r -= I3;
        { const int n0 = (r / 44) * 32, k0 = (r % 44) * 64;
            wconv_item(p.w_down + (size_t)l * DFF * DM, DM, n0, 32, nullptr, (bf16_t*)(ws + WS_WD) + (size_t)l * DM * DFF, DFF, n0, k0, scr, lane); }
    }
    float* cs = (float*)(ws + WS_CS);
    for (int e = blockIdx.x * 512 + tid; e < SEQ * 32; e += gridDim.x * 512) {
        const int pos = e >> 5, i = e & 31;
        const float inv = 1.0f / exp2f((float)i * (13.287712379549449f / 32.f));
        const float ang = (float)pos * inv;
        double t = (double)ang * 0.15915494309189535; t -= __builtin_rint(t);
        const float f = (float)t;
        cs[pos * 64 + i] = __builtin_amdgcn_cosf(f); cs[pos * 64 + 32 + i] = __builtin_amdgcn_sinf(f);
    }
}
DI void norm_rows(const float* src, bf16_t* dst, float* rss) {
    const int tid = opaque_tid(), lane = tid & 63, wave = __builtin_amdgcn_readfirstlane(tid >> 6);
    const int gw = blockIdx.x * 8 + wave, NGW = gridDim.x * 8;
    for (int m = gw; m < MTOK; m += 2 * NGW) {
        const int m2 = (m + NGW < MTOK) ? m + NGW : m;
        const f32x4* xa = (const f32x4*)(src + (size_t)m * DM) + lane; const f32x4* xb2 = (const f32x4*)(src + (size_t)m2 * DM) + lane;
        f32x4 va[4], vb[4]; float sa = 0.f, sb = 0.f;
#pragma unroll
        for (int j = 0; j < 4; ++j) { va[j] = xa[64 * j]; vb[j] = xb2[64 * j]; }
#pragma unroll
        for (int j = 0; j < 4; ++j) { sa += (va[j][0] * va[j][0] + va[j][1] * va[j][1]) + (va[j][2] * va[j][2] + va[j][3] * va[j][3]); sb += (vb[j][0] * vb[j][0] + vb[j][1] * vb[j][1]) + (vb[j][2] * vb[j][2] + vb[j][3] * vb[j][3]); }
        sa = wave_sum(sa, lane); sb = wave_sum(sb, lane);
        if (lane == 0) { rss[m] = sa; rss[m2] = sb; }
        u32x2* oa = (u32x2*)(dst + (size_t)m * DM) + lane; u32x2* ob = (u32x2*)(dst + (size_t)m2 * DM) + lane;
#pragma unroll
        for (int j = 0; j < 4; ++j) { u32x2 w; w[0] = pk2(va[j][0], va[j][1]); w[1] = pk2(va[j][2], va[j][3]); oa[64 * j] = w; u32x2 w2; w2[0] = pk2(vb[j][0], vb[j][1]); w2[1] = pk2(vb[j][2], vb[j][3]); ob[64 * j] = w2; }
    }
}

constexpr int ROWB = 144, VROWB = 264, KS_BYTES = 128 * ROWB, VS_BYTES = 128 * VROWB;
constexpr int LDS_KS = 0, LDS_VS = 2 * KS_BYTES, LDS_TOP = LDS_VS + 3 * VS_BYTES;
constexpr int LDS_BST = LDS_TOP + 64, LDS_MISC = LDS_TOP + 128, LDS_QM = LDS_TOP + 256;
static_assert(LDS_TOP >= 131072 && LDS_QM + 1024 <= 147456, "LDS map");
constexpr float SM_C = 0.125f * 1.44269504089f;
constexpr float RESCALE_THR = 8.f;

template <int DV, int MODE>
DI void flash_pass(unsigned char* lds, const bf16_t* __restrict__ Qp, const bf16_t* __restrict__ Kp, const bf16_t* __restrict__ VTp, int q0,
                   f32x16 (&o)[DV / 32], float& m_run, float& l_run, unsigned qmask, unsigned umask, const u64* bmrow) {
    const int tid = opaque_tid(), lane = tid & 63, wave = __builtin_amdgcn_readfirstlane(tid >> 6), h = lane >> 5, ql = lane & 31;
    const int qw0 = q0 + 32 * wave, q = qw0 + ql;
    bf16x8 qf[4];
#pragma unroll
    for (int ks = 0; ks < 4; ++ks) qf[ks] = *(const GAS bf16x8*)(Qp + (size_t)q * 64 + 16 * ks + 8 * h);
#pragma unroll
    for (int dt = 0; dt < DV / 32; ++dt)
#pragma unroll
        for (int i = 0; i < 16; ++i) o[dt][i] = 0.f;
    m_run = NEG_INF; l_run = 0.f;
    const int ntile = (q0 + 256) >> 7;
    const int krow = tid >> 3, kch = tid & 7;
    const int vrow = tid >> 4, vch = tid & 15;
    int j = 0;
    if (MODE == 1) { while (j < ntile && !((umask >> (j >> 1)) & 1u)) j += 2; }
    u32x4 kreg[2]; u32x4 vreg[DV / 32]; u64 mreg0 = 0, mreg1 = 0;
    kreg[0] = (u32x4){0u, 0u, 0u, 0u}; kreg[1] = kreg[0];
#pragma unroll
    for (int i = 0; i < DV / 32; ++i) vreg[i] = kreg[0];
#define FL_LOADT(jj) do { const int k0_ = (jj) * 128; \
        kreg[0] = *(const GAS u32x4*)(Kp + (size_t)(k0_ + krow) * 64 + kch * 8); kreg[1] = *(const GAS u32x4*)(Kp + (size_t)(k0_ + 64 + krow) * 64 + kch * 8); \
        _Pragma("unroll") for (int i_ = 0; i_ < DV / 32; ++i_) vreg[i_] = *(const GAS u32x4*)(VTp + (size_t)(vrow + 32 * i_) * MTOK + k0_ + vch * 8); \
        if (MODE == 2) { mreg0 = *(const GAS u64*)(bmrow + 2 * (jj)); mreg1 = *(const GAS u64*)(bmrow + 2 * (jj) + 1); } } while (0)
#define FL_STORET(bb, vbb) do { *(u32x4*)(lds + LDS_KS + (bb) * KS_BYTES + krow * ROWB + kch * 16) = kreg[0]; *(u32x4*)(lds + LDS_KS + (bb) * KS_BYTES + (64 + krow) * ROWB + kch * 16) = kreg[1]; \
        _Pragma("unroll") for (int i_ = 0; i_ < DV / 32; ++i_) { unsigned char* vd_ = lds + LDS_VS + (vbb) * VS_BYTES + (vrow + 32 * i_) * VROWB + vch * 16; \
            *(u32x2*)vd_ = (u32x2){vreg[i_][0], vreg[i_][1]}; *(u32x2*)(vd_ + 8) = (u32x2){vreg[i_][2], vreg[i_][3]}; } } while (0)
#define FL_NEXT(jj, out) do { out = (jj) + 1; if (MODE == 1) { while (out < ntile && !((umask >> (out >> 1)) & 1u)) out = (out | 1) + 1; } } while (0)
    __syncthreads();
    u64 mc0 = 0, mc1 = 0; int jn = ntile, cur = 0, vb = 0;
    const bool grpB = (DV == 64) && (wave >= 4);
    u32x4 pprev[8]; int vprev = -1;
#pragma unroll
    for (int e = 0; e < 8; ++e) pprev[e] = (u32x4){0u, 0u, 0u, 0u};
#define FL_VLOAD(DST, G) do { _Pragma("unroll") for (int dt_ = 0; dt_ < DV / 32; ++dt_) { \
        const unsigned char* vp_ = VS_ + (32 * dt_ + ql) * VROWB + (16 * (G) + 4 * h) * 2; \
        (DST)[2 * dt_] = *(const s16x4*)vp_; (DST)[2 * dt_ + 1] = *(const s16x4*)(vp_ + 16); } } while (0)
#define FL_PV(PW, VBUF) do { const unsigned char* VS_ = lds + LDS_VS + (VBUF) * VS_BYTES; \
        s16x4 fa_[2 * (DV / 32)], fb_[2 * (DV / 32)]; \
        FL_VLOAD(fa_, 0); \
        _Pragma("unroll") for (int g_ = 0; g_ < 8; g_ += 2) { \
            FL_VLOAD(fb_, g_ + 1); \
            { const bf16x8 pb_ = __builtin_bit_cast(bf16x8, (PW)[g_]); \
              _Pragma("unroll") for (int dt_ = 0; dt_ < DV / 32; ++dt_) o[dt_] = MFMA32(__builtin_shufflevector(fa_[2 * dt_], fa_[2 * dt_ + 1], 0, 1, 2, 3, 4, 5, 6, 7), pb_, o[dt_]); } \
            if (g_ + 2 < 8) FL_VLOAD(fa_, g_ + 2); \
            { const bf16x8 pb_ = __builtin_bit_cast(bf16x8, (PW)[g_ + 1]); \
              _Pragma("unroll") for (int dt_ = 0; dt_ < DV / 32; ++dt_) o[dt_] = MFMA32(__builtin_shufflevector(fb_[2 * dt_], fb_[2 * dt_ + 1], 0, 1, 2, 3, 4, 5, 6, 7), pb_, o[dt_]); } \
        } } while (0)
    if (j < ntile) {
        FL_LOADT(j); FL_STORET(0, 0); mc0 = mreg0; mc1 = mreg1;
        FL_NEXT(j, jn);
        if (jn < ntile) FL_LOADT(jn);
    }
    __syncthreads();
    while (j < ntile) {
        if (grpB && vprev >= 0) { FL_PV(pprev, vprev); vprev = -1; }
        const bool selq = (MODE == 1) ? (((qmask >> (j >> 1)) & 1u) != 0u) : true;
        u64 selb = ~0ull;
        if (MODE == 1) selb = __ballot(selq);
        const int k0 = j * 128;
        if ((k0 <= qw0 + 31) && (selb != 0ull)) {
            const unsigned char* KS = lds + LDS_KS + cur * KS_BYTES;
            f32x16 st[4];
#pragma unroll
            for (int t = 0; t < 4; ++t)
#pragma unroll
                for (int i = 0; i < 16; ++i) st[t][i] = 0.f;
#pragma unroll
            for (int t = 0; t < 4; ++t)
#pragma unroll
                for (int ks = 0; ks < 4; ++ks) {
                    const bf16x8 ka = *(const bf16x8*)(KS + (32 * t + ql) * ROWB + (16 * ks + 8 * h) * 2);
                    st[t] = MFMA32(ka, qf[ks], st[t]);
                }
            if (MODE == 2) {
#pragma unroll
                for (int t = 0; t < 4; ++t) {
                    const u64 mcur = (t >> 1) ? mc1 : mc0;
                    const unsigned wsel = (unsigned)((t & 1) ? (mcur >> 32) : mcur) >> (4 * h);
#pragma unroll
                    for (int i = 0; i < 16; ++i) { const int kr = (i & 3) + 8 * (i >> 2); st[t][i] = (((wsel >> kr) & 1u) != 0u) ? st[t][i] : NEG_INF; }
                }
            } else {
                const bool need_mask = (k0 + 127 > qw0) || (MODE == 1 && selb != ~0ull);
                if (need_mask) {
                    const int dq = q - k0 - 4 * h;
#pragma unroll
                    for (int t = 0; t < 4; ++t)
#pragma unroll
                        for (int i = 0; i < 16; ++i) { const int kr = (i & 3) + 8 * (i >> 2) + 32 * t; st[t][i] = (selq && (kr <= dq)) ? st[t][i] : NEG_INF; }
                }
            }
            float mx = fmaxf(st[0][0], st[1][0]);
#pragma unroll
            for (int i = 0; i < 16; ++i) mx = fmaxf(fmaxf(mx, st[0][i]), fmaxf(st[1][i], fmaxf(st[2][i], st[3][i])));
            mx = fmaxf(mx, shx(mx, 32, lane)) * SM_C;
            if (__ballot(mx > m_run + RESCALE_THR) != 0ull) {
                const float m_new = fmaxf(m_run, mx), m_ref = (m_new == NEG_INF) ? 0.f : m_new;
                const float alpha = __builtin_amdgcn_exp2f(m_run - m_ref);
#pragma unroll
                for (int dt = 0; dt < DV / 32; ++dt) o[dt] = o[dt] * alpha;
                l_run *= alpha; m_run = m_new;
            }
            const float m_use = (m_run == NEG_INF) ? 0.f : m_run;
            const f32x2_t c2 = {SM_C, SM_C}, nm2 = {-m_use, -m_use};
            f32x2_t ps2 = {0.f, 0.f};
#pragma unroll
            for (int t = 0; t < 4; ++t)
#pragma unroll
                for (int i = 0; i < 16; i += 2) {
                    f32x2_t a2 = {st[t][i], st[t][i + 1]};
                    a2 = a2 * c2 + nm2;
                    f32x2_t e2; e2[0] = __builtin_amdgcn_exp2f(a2[0]); e2[1] = __builtin_amdgcn_exp2f(a2[1]);
                    st[t][i] = e2[0]; st[t][i + 1] = e2[1]; ps2 = ps2 + e2;
                }
            l_run += ps2[0] + ps2[1];
#pragma unroll
            for (int t = 0; t < 4; ++t)
#pragma unroll
                for (int s2 = 0; s2 < 2; ++s2) {
                    pprev[2 * t + s2][0] = pk2(st[t][8 * s2], st[t][8 * s2 + 1]); pprev[2 * t + s2][1] = pk2(st[t][8 * s2 + 2], st[t][8 * s2 + 3]);
                    pprev[2 * t + s2][2] = pk2(st[t][8 * s2 + 4], st[t][8 * s2 + 5]); pprev[2 * t + s2][3] = pk2(st[t][8 * s2 + 6], st[t][8 * s2 + 7]);
                }
            if (!grpB) { FL_PV(pprev, vb); } else vprev = vb;
        }
        int jnn = ntile; u64 mn0 = 0, mn1 = 0;
        const int vbn = (vb == 2) ? 0 : vb + 1;
        if (jn < ntile) { FL_STORET(cur ^ 1, vbn); mn0 = mreg0; mn1 = mreg1; FL_NEXT(jn, jnn); if (jnn < ntile) FL_LOADT(jnn); }
        asm volatile("s_waitcnt lgkmcnt(0)\n\ts_barrier" ::: "memory");
        j = jn; jn = jnn; cur ^= 1; vb = vbn; mc0 = mn0; mc1 = mn1;
    }
    if (grpB && vprev >= 0) { FL_PV(pprev, vprev); }
#undef FL_PV
#undef FL_VLOAD
#undef FL_LOADT
#undef FL_STORET
#undef FL_NEXT
}

DI u32x4 widen_pair(u32x2 a  , u32x2 b  ) {
    const auto r0 = __builtin_amdgcn_permlane32_swap(a[0], b[0], false, false);
    const auto r1 = __builtin_amdgcn_permlane32_swap(a[1], b[1], false, false);
    return (u32x4){r0[0], r1[0], r0[1], r1[1]};
}
DI void write_o64(const f32x16 (&o)[2], float l_run, bf16_t* mixrow  , int wave, int lane) {
    const int h = lane >> 5, ql = lane & 31;
    const float inv = 1.f / (l_run + shx(l_run, 32, lane));
    bf16_t* rp = mixrow + (size_t)(32 * wave + ql) * DM;
#pragma unroll
    for (int dt = 0; dt < 2; ++dt)
#pragma unroll
        for (int pr = 0; pr < 2; ++pr) {
            u32x2 a, b2;
            a[0] = pk2(o[dt][8 * pr] * inv, o[dt][8 * pr + 1] * inv); a[1] = pk2(o[dt][8 * pr + 2] * inv, o[dt][8 * pr + 3] * inv);
            b2[0] = pk2(o[dt][8 * pr + 4] * inv, o[dt][8 * pr + 5] * inv); b2[1] = pk2(o[dt][8 * pr + 6] * inv, o[dt][8 * pr + 7] * inv);
            *(GAS u32x4*)(rp + 32 * dt + 16 * pr + 8 * h) = widen_pair(a, b2);
        }
}

DI void moba_unit(const Params& p, unsigned char* lds, int l, int b, int hh, int cur) {
    const int tid = opaque_tid(), lane = tid & 63, wave = __builtin_amdgcn_readfirstlane(tid >> 6);
    const bf16_t* QK = gp((const bf16_t*)(p.ws + WS_QK));
    const bf16_t* Qp = QK + ((size_t)(0 + hh) * MTOK + (size_t)b * SEQ) * 64;
    const bf16_t* Kp = QK + ((size_t)(4 + hh) * MTOK + (size_t)b * SEQ) * 64;
    const bf16_t* VTp = gp((const bf16_t*)(p.ws + WS_VT)) + (size_t)(64 * hh) * MTOK + (size_t)b * SEQ;
    const float* kmean = gp((const float*)(p.ws + WS_KMEAN)) + (size_t)l * 32768;
    volatile unsigned* QM = (volatile unsigned*)(lds + LDS_QM); unsigned* MISC = (unsigned*)(lds + LDS_MISC);
    const int q0 = cur * 256;
    float* kml = (float*)(lds + LDS_KS);
    for (int e = tid; e < cur * 64; e += 512) kml[e] = kmean[((size_t)(b * 16 + (e >> 6)) * 4 + hh) * 64 + (e & 63)];
    __syncthreads();
    if (tid < 256) {
        const u32x4* qr = (const u32x4*)(Qp + (size_t)(q0 + tid) * 64);
        float qv[64];
#pragma unroll
        for (int c = 0; c < 8; ++c) { const u32x4 w = qr[c];
#pragma unroll
            for (int e = 0; e < 4; ++e) { qv[8 * c + 2 * e] = bf_lo(w[e]); qv[8 * c + 2 * e + 1] = bf_hi(w[e]); } }
        float b0 = NEG_INF, b1 = NEG_INF, b2 = NEG_INF; int i0 = -1, i1 = -1, i2 = -1;
        for (int n = 0; n < cur; ++n) {
            const f32x4* km = (const f32x4*)(kml + n * 64);
            float g = 0.f;
#pragma unroll
            for (int d4 = 0; d4 < 16; ++d4) { const f32x4 k4 = km[d4]; g = fmaf(qv[4 * d4], k4[0], g); g = fmaf(qv[4 * d4 + 1], k4[1], g); g = fmaf(qv[4 * d4 + 2], k4[2], g); g = fmaf(qv[4 * d4 + 3], k4[3], g); }
            if (g > b0) { b2 = b1; i2 = i1; b1 = b0; i1 = i0; b0 = g; i0 = n; }
            else if (g > b1) { b2 = b1; i2 = i1; b1 = g; i1 = n; }
            else if (g > b2) { b2 = g; i2 = n; }
        }
        unsigned mask = 1u << cur;
        if (i0 >= 0) mask |= 1u << i0; if (i1 >= 0) mask |= 1u << i1; if (i2 >= 0) mask |= 1u << i2;
        QM[tid] = mask; atomicOr(&MISC[1], mask);
    }
    __syncthreads();
    const unsigned umask = MISC[1], qmask = QM[32 * wave + (lane & 31)];
    f32x16 o[2]; float m_run, l_run;
    flash_pass<64, 1>(lds, Qp, Kp, VTp, q0, o, m_run, l_run, qmask, umask, nullptr);
    write_o64(o, l_run, gp((bf16_t*)p.out + (size_t)MTOK * DM) + ((size_t)b * SEQ + q0) * DM + 64 * hh, wave, lane);
}

DI void dsa_unit(const Params& p, unsigned char* lds, int b, int hh, int cur) {
    const int tid = opaque_tid(), lane = tid & 63, wave = __builtin_amdgcn_readfirstlane(tid >> 6);
    const bf16_t* QK = gp((const bf16_t*)(p.ws + WS_QK));
    const bf16_t* Qp = QK + ((size_t)(24 + hh) * MTOK + (size_t)b * SEQ) * 64;
    const bf16_t* Kp = QK + ((size_t)(28 + hh) * MTOK + (size_t)b * SEQ) * 64;
    const bf16_t* VTp = gp((const bf16_t*)(p.ws + WS_VT)) + (size_t)(768 + 64 * hh) * MTOK + (size_t)b * SEQ;
    const int q0 = cur * 256;
    const u64* bmrow = gp((const u64*)(p.ws + WS_BM)) + ((size_t)b * SEQ + q0 + 32 * wave + (lane & 31)) * 64;
    f32x16 o[2]; float m_run, l_run;
    flash_pass<64, 2>(lds, Qp, Kp, VTp, q0, o, m_run, l_run, 0u, 0u, bmrow);
    write_o64(o, l_run, gp((bf16_t*)p.out + (size_t)MTOK * DM) + ((size_t)b * SEQ + q0) * DM + 768 + 64 * hh, wave, lane);
}

DI void diff_unit(const Params& p, unsigned char* lds, int l, int b, int hh, int cur) {
    const int tid = opaque_tid(), lane = tid & 63, wave = __builtin_amdgcn_readfirstlane(tid >> 6), h = lane >> 5, ql = lane & 31;
    const bf16_t* QK = gp((const bf16_t*)(p.ws + WS_QK));
    const bf16_t* VTp = gp((const bf16_t*)(p.ws + WS_VT)) + (size_t)(256 + 128 * hh) * MTOK + (size_t)b * SEQ;
    const int q0 = cur * 256;
    f32x16 o1[4]; float m1, l1;
    float* sto = gp((float*)(p.ws + WS_SCR)) + (size_t)blockIdx.x * (32 * SEQ) + (size_t)(32 * wave + ql) * 128;
    flash_pass<128, 0>(lds, QK + ((size_t)(8 + 2 * hh) * MTOK + (size_t)b * SEQ) * 64, QK + ((size_t)(16 + 2 * hh) * MTOK + (size_t)b * SEQ) * 64, VTp, q0, o1, m1, l1, 0u, 0u, nullptr);
    {
        const float r1 = 1.f / (l1 + shx(l1, 32, lane));
#pragma unroll
        for (int dt = 0; dt < 4; ++dt)
#pragma unroll
            for (int g = 0; g < 4; ++g) { f32x4 v = {o1[dt][4 * g] * r1, o1[dt][4 * g + 1] * r1, o1[dt][4 * g + 2] * r1, o1[dt][4 * g + 3] * r1}; *(f32x4*)(sto + 32 * dt + 8 * g + 4 * h) = v; }
    }
    flash_pass<128, 0>(lds, QK + ((size_t)(9 + 2 * hh) * MTOK + (size_t)b * SEQ) * 64, QK + ((size_t)(17 + 2 * hh) * MTOK + (size_t)b * SEQ) * 64, VTp, q0, o1, m1, l1, 0u, 0u, nullptr);
    const float* lp = p.dlam + l * 256;
    float d1 = 0.f, d2 = 0.f;
    for (int d = 0; d < 64; ++d) { d1 = fmaf(lp[d], lp[64 + d], d1); d2 = fmaf(lp[128 + d], lp[192 + d], d2); }
    const float lam_init = (l == 0) ? 0.2f : (0.8f - 0.6f * 0.7408182206817179f);
    const float lam = expf(d1) - expf(d2) + lam_init;
    const float r2 = lam / (l1 + shx(l1, 32, lane));
    float ss = 0.f;
#pragma unroll
    for (int dt = 0; dt < 4; ++dt)
#pragma unroll
        for (int g = 0; g < 4; ++g) {
            const f32x4 a = *(const f32x4*)(sto + 32 * dt + 8 * g + 4 * h);
#pragma unroll
            for (int e = 0; e < 4; ++e) { const float v = a[e] - o1[dt][4 * g + e] * r2; o1[dt][4 * g + e] = v; ss = fmaf(v, v, ss); }
        }
    ss += shx(ss, 32, lane);
    const float rn = rsqrtf(ss * (1.f / 128.f) + EPS) * (1.f - lam_init);
    const float* sg = p.subln + l * 128;
    bf16_t* rp = gp((bf16_t*)p.out + (size_t)MTOK * DM) + ((size_t)b * SEQ + q0 + 32 * wave + ql) * DM + 256 + 128 * hh;
#pragma unroll
    for (int dt = 0; dt < 4; ++dt)
#pragma unroll
        for (int pr = 0; pr < 2; ++pr) {
            u32x2 ab[2];
#pragma unroll
            for (int e = 0; e < 2; ++e) {
                const int g = 2 * pr + e, d0 = 32 * dt + 8 * g + 4 * h;
                const f32x4 gv = *(const f32x4*)(sg + d0);
                ab[e][0] = pk2(o1[dt][4 * g] * rn * gv[0], o1[dt][4 * g + 1] * rn * gv[1]); ab[e][1] = pk2(o1[dt][4 * g + 2] * rn * gv[2], o1[dt][4 * g + 3] * rn * gv[3]);
            }
            *(GAS u32x4*)(rp + 32 * dt + 16 * pr + 8 * h) = widen_pair(ab[0], ab[1]);
        }
}

DI unsigned ord_key(float v) { v += 0.f; const unsigned b = __builtin_bit_cast(unsigned, v); return b ^ ((b & 0x80000000u) ? 0xffffffffu : 0x80000000u); }
constexpr int LDS_SEL = 61440, SEL_STRIDE = 6144;
DI float key_f(unsigned u) { const unsigned b = (u & 0x80000000u) ? (u ^ 0x80000000u) : ~u; return __builtin_bit_cast(float, b); }
DI void select_unit(const Params& p, unsigned char* lds, int b, int q0) {
    const int tid = opaque_tid(), lane = tid & 63, wave = __builtin_amdgcn_readfirstlane(tid >> 6);
    float* scr = gp((float*)(p.ws + WS_SCR)) + (size_t)blockIdx.x * (32 * SEQ);
    u64* bm = gp((u64*)(p.ws + WS_BM));
    if (q0 >= 256) {
        const bf16_t* QK = gp((const bf16_t*)(p.ws + WS_QK));
        const bf16_t* IK = QK + ((size_t)40 * MTOK + (size_t)b * SEQ) * 64;
        const int qi = lane & 15, kq = lane >> 4, qrow = 16 * (wave >> 2) + qi, kw = wave & 3;
        const float* iwp = gp((const float*)(p.ws + WS_IW)) + ((size_t)b * SEQ + q0 + qrow) * 8;
        bf16x8 qf[8][2]; float w[8];
        const f32x4 wa = *(const f32x4*)iwp, wb = *(const f32x4*)(iwp + 4);
#pragma unroll
        for (int e = 0; e < 4; ++e) { w[e] = wa[e]; w[4 + e] = wb[e]; }
#pragma unroll
        for (int hh = 0; hh < 8; ++hh)
#pragma unroll
            for (int ks = 0; ks < 2; ++ks) qf[hh][ks] = *(const bf16x8*)(QK + ((size_t)(32 + hh) * MTOK + (size_t)b * SEQ + q0 + qrow) * 64 + 32 * ks + 8 * kq);
        const int n32 = (q0 + 32) >> 5;
        const bf16_t* kbase = IK + (size_t)qi * 64 + 8 * kq;
        for (int srep = 0; srep < SEL_REP_SCORE; ++srep) {
        bf16x8 kf[2][2];
        if (kw < n32) {
#pragma unroll
            for (int sub = 0; sub < 2; ++sub)
#pragma unroll
                for (int ks = 0; ks < 2; ++ks) kf[sub][ks] = *(const GAS bf16x8*)(kbase + (size_t)(32 * kw + 16 * sub) * 64 + 32 * ks);
        }
#pragma unroll 1
        for (int t = kw; t < n32; t += 4) {
            const int k0 = 32 * t;
            bf16x8 kn[2][2];
            const int tn = (t + 4 < n32) ? t + 4 : t;
#pragma unroll
            for (int sub = 0; sub < 2; ++sub)
#pragma unroll
                for (int ks = 0; ks < 2; ++ks) kn[sub][ks] = *(const GAS bf16x8*)(kbase + (size_t)(32 * tn + 16 * sub) * 64 + 32 * ks);
            f32x4 sc[2];
#pragma unroll
            for (int sub = 0; sub < 2; ++sub) sc[sub] = (f32x4){0.f, 0.f, 0.f, 0.f};
#pragma unroll
            for (int hh = 0; hh < 8; ++hh)
#pragma unroll
                for (int sub = 0; sub < 2; ++sub) {
                    f32x4 a = {0.f, 0.f, 0.f, 0.f};
                    a = __builtin_amdgcn_mfma_f32_16x16x32_bf16(kf[sub][0], qf[hh][0], a, 0, 0, 0);
                    a = __builtin_amdgcn_mfma_f32_16x16x32_bf16(kf[sub][1], qf[hh][1], a, 0, 0, 0);
#pragma unroll
                    for (int i = 0; i < 4; ++i) sc[sub][i] = fmaf(w[hh], fmaxf(a[i], 0.f), sc[sub][i]);
                    if (sub == 1 && (hh & 3) == 3) __builtin_amdgcn_sched_barrier(0);
                }
#pragma unroll
            for (int sub = 0; sub < 2; ++sub) *(GAS f32x4*)(scr + (size_t)qrow * SEQ + k0 + 16 * sub + 4 * kq) = sc[sub];
#pragma unroll
            for (int sub = 0; sub < 2; ++sub)
#pragma unroll
                for (int ks = 0; ks < 2; ++ks) kf[sub][ks] = kn[sub][ks];
        }
        }
        __syncthreads();
    }
    LAS unsigned* hist = (LAS unsigned*)((LAS unsigned char*)lds + LDS_SEL + wave * SEL_STRIDE + 16);
    LAS float* listv = (LAS float*)(hist + 1024);
    LAS int* listi = (LAS int*)(hist + 1088);
    LAS unsigned* misc = hist + 1152;
#define SEL_CB() asm volatile("" ::: "memory")
#define SEL_WAIT() asm volatile("s_waitcnt lgkmcnt(0)" ::: "memory")
#pragma unroll 1
    for (int rr0 = 0; rr0 < 4 * SEL_REP_ROWS; ++rr0) {
        const int rr = rr0 & 3;
        const int r = wave * 4 + rr, qpos = q0 + r;
        int ln = lane; asm volatile("" : "+v"(ln));
        u64* bmr = bm + ((size_t)b * SEQ + qpos) * 64;
        if (qpos < 256) {
            const int rem = qpos - ln * 64;
            bmr[ln] = (rem >= 63) ? ~0ull : (rem < 0) ? 0ull : ((2ull << rem) - 1ull);
            continue;
        }
        const int ng = (qpos >> 9) + 1;
        float v[64];
        const float* sr = scr + (size_t)r * SEQ;
#pragma unroll
        for (int g8 = 0; g8 < 8; ++g8) {
#pragma unroll
            for (int jj = 0; jj < 8; ++jj) v[8 * g8 + jj] = NEG_INF;
            if (g8 < ng) {
#pragma unroll
                for (int jj = 0; jj < 8; ++jj) { const int j = 8 * g8 + jj; const float t = *(const GAS float*)(sr + 64 * j + ln); v[j] = (ln <= qpos - 64 * j) ? (t + 0.f) : NEG_INF; }
            }
        }
        float lmax = NEG_INF, lmin = -NEG_INF;
#pragma unroll
        for (int g8 = 0; g8 < 8; ++g8) {
            if (g8 < ng) {
#pragma unroll
                for (int jj = 0; jj < 8; ++jj) { const int j = 8 * g8 + jj; lmax = fmaxf(lmax, v[j]); lmin = fminf(lmin, (v[j] == NEG_INF) ? -NEG_INF : v[j]); }
            }
        }
        SEL_WAIT();
        if (ln == 0) { misc[0] = 0u; misc[1] = 0xffffffffu; misc[2] = 0u; }
        {
            LAS u32x4* hz = (LAS u32x4*)(hist + 16 * ln);
            const u32x4 z = {0u, 0u, 0u, 0u};
            hz[0] = z; hz[1] = z; hz[2] = z; hz[3] = z;
        }
        SEL_CB();
        atomicMax((unsigned*)&misc[0], ord_key(lmax)); atomicMin((unsigned*)&misc[1], ord_key(lmin));
        SEL_WAIT();
        const float hi = key_f(misc[0]), lo = key_f(misc[1]);
        const float inv = 1024.f / (hi - lo), c0 = -lo * inv;
        bool fast = (hi > lo) && (inv < 1e37f);
        float Tv = 0.f; int Ti = 0;
        if (fast) {
            unsigned pb[32];
#pragma unroll
            for (int e = 0; e < 32; ++e) pb[e] = 0u;
#pragma unroll
            for (int g8 = 0; g8 < 8; ++g8) {
                if (g8 < ng) {
#pragma unroll
                    for (int jj = 0; jj < 8; ++jj) { const int j = 8 * g8 + jj;
                        int bin = (int)fmaf(v[j], inv, c0); bin = bin < -1 ? -1 : (bin > 1023 ? 1023 : bin);
                        atomicAdd((unsigned*)(hist + bin), 1u);
                        for (int xa = 0; xa < PROBE_XATOM; ++xa) atomicAdd((unsigned*)(hist + bin), 0u);
                        pb[j >> 1] |= (unsigned)(bin + 1) << (16 * (j & 1)); }
                }
            }
            SEL_WAIT();
            unsigned c[16]; unsigned tot = 0;
            {
                LAS u32x4* hz = (LAS u32x4*)(hist + 16 * ln);
#pragma unroll
                for (int e = 0; e < 4; ++e) { const u32x4 t4 = hz[e]; c[4 * e] = t4[0]; c[4 * e + 1] = t4[1]; c[4 * e + 2] = t4[2]; c[4 * e + 3] = t4[3]; tot += t4[0] + t4[1] + t4[2] + t4[3]; }
            }
            unsigned suf = tot;
#pragma unroll
            for (int d = 1; d < 64; d <<= 1) { const unsigned o = (unsigned)__builtin_amdgcn_ds_bpermute(((ln + d) & 63) << 2, (int)suf); suf += (ln + d < 64) ? o : 0u; }
            const u64 ge = __ballot(suf >= 256u);
            const int Ls = 63 - __builtin_clzll(ge);
            unsigned cum = suf - tot; int bsel = 0; unsigned above = 0, cstar = 0; bool found = false;
#pragma unroll
            for (int t = 15; t >= 0; --t) { if (!found && cum + c[t] >= 256u) { found = true; bsel = 16 * ln + t; above = cum; cstar = c[t]; } cum += c[t]; }
            const int bstar = __builtin_amdgcn_readlane(bsel, Ls); const int need = 256 - __builtin_amdgcn_readlane((int)above, Ls); const int ncand = __builtin_amdgcn_readlane((int)cstar, Ls);
            if (ncand > 64) fast = false;
            else {
                SEL_CB();
                const unsigned blo = (unsigned)(bstar + 1), bhi = blo << 16;
#pragma unroll
                for (int g8 = 0; g8 < 8; ++g8) {
                    if (g8 < ng) {
#pragma unroll
                        for (int jj = 0; jj < 8; ++jj) { const int j = 8 * g8 + jj;
                            const bool is = (j & 1) ? ((pb[j >> 1] & 0xffff0000u) == bhi) : ((pb[j >> 1] & 0xffffu) == blo);
                            if (is) { const unsigned pos = atomicAdd((unsigned*)&misc[2], 1u); listv[pos & 63] = v[j]; listi[pos & 63] = 64 * j + ln; } }
                    }
                }
                SEL_WAIT();
                const float mv = listv[ln]; const int mi = listi[ln];
                int rank = 0;
                for (int i = 0; i < ncand; ++i) { const float ov = listv[i]; const int oi = listi[i]; rank += ((ov > mv) || (ov == mv && oi < mi)) ? 1 : 0; }
                const u64 hit = __ballot(ln < ncand && rank == need - 1);
                const int Lt = __builtin_ctzll(hit);
                Tv = __builtin_bit_cast(float, __builtin_amdgcn_readlane(__builtin_bit_cast(int, mv), Lt)); Ti = __builtin_amdgcn_readlane(mi, Lt);
            }
        }
        if (!fast) {
            unsigned T = 0u;
#pragma unroll 1
            for (int bit = 31; bit >= 0; --bit) {
                const unsigned cand = T | (1u << bit);
                int cc = 0;
#pragma unroll
                for (int j = 0; j < 64; ++j) cc += (v[j] != NEG_INF && ord_key(v[j]) >= cand) ? 1 : 0;
                int totc = 0;
#pragma unroll
                for (int bb = 0; bb < 7; ++bb) totc += __builtin_popcountll(__ballot((cc >> bb) & 1)) << bb;
                if (totc >= 256) T = cand;
            }
            Tv = key_f(T);
            int cc = 0;
#pragma unroll
            for (int j = 0; j < 64; ++j) cc += (v[j] > Tv) ? 1 : 0;
            int cgt = 0;
#pragma unroll
            for (int bb = 0; bb < 7; ++bb) cgt += __builtin_popcountll(__ballot((cc >> bb) & 1)) << bb;
            const int need = 256 - cgt;
            int taken = 0; Ti = -1;
#pragma unroll
            for (int j = 0; j < 64; ++j) {
                const u64 eq = __ballot(v[j] == Tv);
                const int ce = __builtin_popcountll(eq);
                if (Ti < 0 && taken + ce >= need) {
                    int k = need - taken; u64 e = eq; int lanepos = 0;
                    while (k > 0) { lanepos = __builtin_ctzll(e); e &= e - 1; --k; }
                    Ti = 64 * j + lanepos;
                }
                taken += ce;
            }
        }
        unsigned wlo = 0u, whi = 0u;
#pragma unroll
        for (int g8 = 0; g8 < 8; ++g8) {
            if (g8 < ng) {
#pragma unroll
                for (int jj = 0; jj < 8; ++jj) { const int j = 8 * g8 + jj;
                    const u64 word = __ballot((v[j] > Tv) || (v[j] == Tv && ln <= Ti - 64 * j));
                    if (ln == j) { wlo = (unsigned)word; whi = (unsigned)(word >> 32); } }
            }
        }
        *(GAS u64*)(bmr + ln) = (u64)wlo | ((u64)whi << 32);
    }
#undef SEL_CB
#undef SEL_WAIT
}

DI void kmean_unit(const Params& p, unsigned char* lds, int l, int b, int hh, int blk) {
    const int tid = opaque_tid(), lane = tid & 63, wave = __builtin_amdgcn_readfirstlane(tid >> 6), ch = tid & 7, rg = tid >> 3;
    const bf16_t* Kp = gp((const bf16_t*)(p.ws + WS_QK)) + ((size_t)(4 + hh) * MTOK + (size_t)b * SEQ + blk * 256) * 64;
    float a[8];
#pragma unroll
    for (int e = 0; e < 8; ++e) a[e] = 0.f;
#pragma unroll
    for (int i = 0; i < 4; ++i) { const u32x4 w = *(const u32x4*)(Kp + (size_t)(rg + 64 * i) * 64 + ch * 8);
#pragma unroll
        for (int e = 0; e < 4; ++e) { a[2 * e] += bf_lo(w[e]); a[2 * e + 1] += bf_hi(w[e]); } }
#pragma unroll
    for (int e = 0; e < 8; ++e) { float v = a[e]; v += shx(v, 8, lane); v += shx(v, 16, lane); v += shx(v, 32, lane); a[e] = v; }
    float* red = (float*)(lds + LDS_KS);
    if (lane < 8) {
#pragma unroll
        for (int e = 0; e < 8; ++e) red[wave * 64 + lane * 8 + e] = a[e];
    }
    __syncthreads();
    if (tid < 64) { float sacc = 0.f;
#pragma unroll
        for (int w = 0; w < 8; ++w) sacc += red[w * 64 + tid];
        (gp((float*)(p.ws + WS_KMEAN)))[(size_t)l * 32768 + ((size_t)(b * 16 + blk) * 4 + hh) * 64 + tid] = sacc * (1.f / 256.f); }
}

#define XB_TMO      128
#define XB_XCNT(j)  (256  + 64 * (j))
#define XB_XSUB(j)  (1280 + 64 * (j))
#define XB_XGEN(j)  (2304 + 64 * (j))
#define XB_TOP      3328
#define XB_TOPGEN   3392
#define XCD_BAR_WORDS 3456
#define XB_SPIN_CAP (1u << 18)

__device__ __forceinline__ unsigned xb_ld(unsigned* p)              { return __hip_atomic_load(p, __ATOMIC_RELAXED, __HIP_MEMORY_SCOPE_AGENT); }
__device__ __forceinline__ unsigned xb_add(unsigned* p, unsigned v) { return __hip_atomic_fetch_add(p, v, __ATOMIC_RELAXED, __HIP_MEMORY_SCOPE_AGENT); }
__device__ __forceinline__ unsigned xb_xcc_id() { return (unsigned)__builtin_amdgcn_s_getreg((3 << 11) | 20) & 0xFu; }
#define XB_SPIN(cond, bar) do { unsigned _sp = 0; while (cond) { __builtin_amdgcn_s_sleep(1); \
    if ((++_sp & 255u) == 0u) { if (xb_ld(&(bar)[XB_TMO])) break; if (_sp > XB_SPIN_CAP) { atomicAdd(&(bar)[XB_TMO], 1u); break; } } } } while (0)

struct XcdBarrier {
    unsigned* bar; unsigned x;
    volatile LAS unsigned* st;
};

__device__ __forceinline__ XcdBarrier xcd_barrier_post(unsigned* bar, volatile LAS unsigned* st) {
    XcdBarrier b; b.bar = bar; b.x = xb_xcc_id(); b.st = st;
    if (threadIdx.x == 0) (void)xb_add(&bar[XB_XCNT(b.x)], 1u);
    return b;
}
__device__ __forceinline__ void xcd_barrier_complete(unsigned* bar, unsigned x, unsigned& nloc, unsigned& nx) {
    const unsigned G = gridDim.x * gridDim.y * gridDim.z;
    unsigned sum, cnt, mine, sp = 0u;
    for (;;) {
        sum = 0u; cnt = 0u; mine = 0u;
#pragma unroll
        for (unsigned j = 0; j < 16; ++j) { const unsigned c = xb_ld(&bar[XB_XCNT(j)]); sum += c; cnt += (c > 0u) ? 1u : 0u; mine = (j == x) ? c : mine; }
        if (sum == G) break;
        __builtin_amdgcn_s_sleep(1);
        if ((++sp & 255u) == 0u) { if (xb_ld(&bar[XB_TMO])) break; if (sp > XB_SPIN_CAP) { atomicAdd(&bar[XB_TMO], 1u); break; } }
    }
    nloc = mine > 0u ? mine : 1u; nx = cnt > 0u ? cnt : 1u;
}

__device__ __forceinline__ void xcd_barrier(const XcdBarrier& b) {
    asm volatile("s_waitcnt vmcnt(0)" ::: "memory");
    __syncthreads();
    if (threadIdx.x == 0) {
        unsigned* bar = b.bar;
        __builtin_amdgcn_s_waitcnt(0);
        unsigned nloc = b.st[0], nx = b.st[1];
        if (nloc == 0u) { xcd_barrier_complete(bar, b.x, nloc, nx); b.st[0] = nloc; b.st[1] = nx; }
        const unsigned old = xb_add(&bar[XB_XSUB(b.x)], 1u);
        const unsigned gen = old / nloc;
        if (old + 1u == (gen + 1u) * nloc) {
            __builtin_amdgcn_fence(__ATOMIC_RELEASE, "agent");
            asm volatile("s_waitcnt vmcnt(0)" ::: "memory");
            const unsigned og = xb_add(&bar[XB_TOP], 1u);
            const unsigned tg = og / nx;
            if (og + 1u == (tg + 1u) * nx) xb_add(&bar[XB_TOPGEN], 1u);
            else XB_SPIN(xb_ld(&bar[XB_TOPGEN]) == tg, bar);
            __builtin_amdgcn_fence(__ATOMIC_ACQUIRE, "agent");
            xb_add(&bar[XB_XGEN(b.x)], 1u);
            asm volatile("s_waitcnt vmcnt(0)" ::: "memory");
        } else {
            XB_SPIN(xb_ld(&bar[XB_XGEN(b.x)]) == gen, bar);
            __builtin_amdgcn_fence(__ATOMIC_ACQUIRE, "agent");
            asm volatile("s_waitcnt vmcnt(0)" ::: "memory");
        }
    }
    __syncthreads();
}

DI int next_item(unsigned char* lds, unsigned* ctr) {
    unsigned* MISC = (unsigned*)(lds + LDS_MISC);
    __syncthreads();
    if (opaque_tid() == 0) { MISC[0] = atomicAdd(ctr, 1u); MISC[1] = 0u; }
    __syncthreads();
    return (int)MISC[0];
}

__global__ void __launch_bounds__(512, 2) mega_fwd(Params p) {
    extern __shared__ __attribute__((aligned(16))) unsigned char lds[];
    cg::grid_group grid = cg::this_grid();
    const int tid = opaque_tid(), lane = tid & 63, wave = __builtin_amdgcn_readfirstlane(tid >> 6);
    PG8_LAS unsigned char* lds3 = (PG8_LAS unsigned char*)lds;
    const Params& p0 = p;
    if (p0.ph_lo < 0) grid.sync();
    volatile LAS unsigned* bst = (volatile LAS unsigned*)(lds3 + LDS_BST);
    if (threadIdx.x == 0) { bst[0] = 0u; bst[1] = 0u; }
    __syncthreads();
    const XcdBarrier gbar = xcd_barrier_post((unsigned*)(p0.ws + WS_CTL) + CW_BAR, bst);
#define GSYNC() xcd_barrier(gbar)
    for (int xs = 0; xs < EXTRA_SYNCS; ++xs) GSYNC();
    for (int ph = p0.ph_lo; ph < p0.ph_hi; ++ph) {
        if ((ph & 7) == 5 || ph == 8) continue;
        if (ph > p0.ph_lo) GSYNC();
        Params p = p0;
        { unsigned char* w_ = p0.ws; asm volatile("" : "+s"(w_)); p.ws = (unsigned char*)(__attribute__((address_space(1))) unsigned char*)w_; }
        unsigned char* ws = p.ws;
        bf16_t* XB = (bf16_t*)(ws + WS_XB);
        unsigned* ctr = (unsigned*)(ws + WS_CTL);
        const int l = ph >> 3, k = ph & 7;
        const float* xin = (l == 0) ? p.x : p.out;
        const int nrep = ((REP_MASK >> k) & 1) ? 2 : 1;
        for (int rep = 0; rep < nrep; ++rep) {
        if (rep > 0) GSYNC();
        if (k == 0 && (PH_MASK & 1)) {
            if (l == 0) prologue_weights(p, lds);
            norm_rows(xin, XB, (float*)(ws + WS_RSS));
        } else if (k == 1 && (PH_MASK & 2)) {
#if !defined(SKIP_G1A)
            const bf16_t* XA = (l == 0) ? XB : (const bf16_t*)p.out;
            { pg8::Gemm g{XA, (const bf16_t*)(ws + WS_W1A) + (size_t)l * N1A * DM, MTOK, N1A, DM}; pg8::StaticOrder S; S.init(MTOK, N1A, gridDim.x, blockIdx.x);
              EpiQK E{(bf16_t*)(ws + WS_QK), (float*)(ws + WS_IW), (const float*)(ws + WS_CS), p.qg + l * 192, p.kg + l * 192, (const float*)(ws + WS_RSS) + (size_t)(2 * l) * MTOK};
              pg8::gemm_phase<EpiQK, pg8::StaticOrder, true, true>(lds3, g, S, E); }
#endif
#if !defined(SKIP_G1B)
            { pg8::Gemm g{(const bf16_t*)(ws + WS_W1B) + (size_t)l * DM * DM, XA, DM, MTOK, DM}; pg8::StaticOrder S; S.init(DM, MTOK, gridDim.x, blockIdx.x);
              EpiVT E{(bf16_t*)(ws + WS_VT), MTOK, (const float*)(ws + WS_RSS) + (size_t)(2 * l) * MTOK};
              pg8::gemm_phase<EpiVT, pg8::StaticOrder, true, true>(lds3, g, S, E); }
#endif
        } else if (k == 2 && (PH_MASK & 4)) {
            for (;;) {
                const int it = next_item(lds, ctr + 16 * (2 * l) + 64 * rep);
                if (it >= 512 + 1024 + 128) break;
                if (it < 512) {
#if !defined(SKIP_DIFF)
                    if (!(REP_SKIP_DIFF && rep > 0)) diff_unit(p, lds, l, (it & 31) >> 2, it & 3, 15 - (it >> 5));
#endif
                } else if (it < 1536) {
#if !defined(SKIP_SEL)
                    const int s = it - 512; select_unit(p, lds, s & 7, 32 * (127 - (s >> 3)));
#endif
                } else { const int s = it - 1536;
                    for (int hh = 0; hh < 4; ++hh) { __syncthreads(); kmean_unit(p, lds, l, s >> 4, hh, s & 15); } }
            }
        } else if (k == 3 && (PH_MASK & 8)) {
            for (;;) {
                const int it = next_item(lds, ctr + 16 * (2 * l + 1) + 64 * rep);
                if (it >= 1024) break;
                const int c = 15 - (it >> 6), bh = it & 31;
                if (((it >> 5) & 1) == 0) dsa_unit(p, lds, bh >> 2, bh & 3, c); else moba_unit(p, lds, l, bh >> 2, bh & 3, c);
            }
        } else if (k == 4 && (PH_MASK & 16)) {
            pg8::Gemm g{(const bf16_t*)p.out + (size_t)MTOK * DM, (const bf16_t*)(ws + WS_WO) + (size_t)l * DM * DM, MTOK, DM, DM};     pg8::StaticOrder S; S.init(MTOK, DM, gridDim.x, blockIdx.x);
            EpiRes E{nullptr, (l == 0) ? (const bf16_t*)XB : (const bf16_t*)p.out, nullptr, (bf16_t*)(ws + WS_SCR), (float*)(ws + WS_RSS) + (size_t)(2 * l + 1) * MTOK};
            pg8::gemm_phase<EpiRes, pg8::StaticOrder, true, true>(lds3, g, S, E);
        } else if (k == 5 && (PH_MASK & 32)) {
        } else if (k == 6 && (PH_MASK & 64)) {
            pg8::Gemm g{(const bf16_t*)(ws + WS_SCR), (const bf16_t*)(ws + WS_W3) + (size_t)l * 2 * DFF * DM, MTOK, 2 * DFF, DM}; pg8::StaticOrder S; S.init(MTOK, 2 * DFF, gridDim.x, blockIdx.x);
            EpiSwi E{(bf16_t*)(ws + WS_H), (const float*)(ws + WS_RSS) + (size_t)(2 * l + 1) * MTOK};
            pg8::gemm_phase<EpiSwi, pg8::StaticOrder, true, true>(lds3, g, S, E);
        } else if (PH_MASK & 128) {
            pg8::Gemm g{(const bf16_t*)(ws + WS_H), (const bf16_t*)(ws + WS_WD) + (size_t)l * DM * DFF, MTOK, DM, DFF}; pg8::StaticOrder S; S.init(MTOK, DM, gridDim.x, blockIdx.x);
            EpiRes E{nullptr, (const bf16_t*)(ws + WS_SCR), (l == 0) ? nullptr : p.out, (l == 0) ? (bf16_t*)p.out : nullptr, (l == 0) ? (float*)(ws + WS_RSS) + (size_t)2 * MTOK : nullptr};
            pg8::gemm_phase<EpiRes, pg8::StaticOrder, true, true>(lds3, g, S, E);
        }
        }
    }
}

#ifndef ONE_LAUNCH_X
#define ONE_LAUNCH 1
#endif
extern "C" void kernel_launch(void* const* d_in, const int* in_sizes, int n_in, void* d_out, int out_size, void* d_ws, size_t ws_size, hipStream_t stream) {
    static int grid = 0;
    if (grid == 0) {
        if (n_in != 12 || ws_size < WS_END) { fprintf(stderr, "kernel_launch: unexpected n_in %d / ws %zu\n", n_in, ws_size); grid = -1; return; }
        int dev = 0, cus = 0, per_cu = 0;
        hipGetDevice(&dev); hipDeviceGetAttribute(&cus, hipDeviceAttributeMultiprocessorCount, dev);
        if (hipFuncSetAttribute((const void*)mega_fwd, hipFuncAttributeMaxDynamicSharedMemorySize, LDS_BYTES) != hipSuccess) { fprintf(stderr, "hipFuncSetAttribute failed\n"); grid = -1; return; }
        hipOccupancyMaxActiveBlocksPerMultiprocessor(&per_cu, (const void*)mega_fwd, 512, LDS_BYTES);
        (void)hipGetLastError();
        if (per_cu < 1) per_cu = 1;
        grid = cus * per_cu; if (grid > 256) grid = 256;
    }
    if (grid < 0) return;
    hipMemsetAsync((char*)d_ws + WS_CTL, 0, CTL_BYTES, stream);
    Params p{};
    p.x = (const float*)d_in[0]; p.attn_g = (const float*)d_in[1]; p.w_in = (const float*)d_in[2]; p.qg = (const float*)d_in[3]; p.kg = (const float*)d_in[4];
    p.dlam = (const float*)d_in[5]; p.subln = (const float*)d_in[6]; p.w_out = (const float*)d_in[7]; p.ffn_g = (const float*)d_in[8];
    p.w_gate = (const float*)d_in[9]; p.w_up = (const float*)d_in[10]; p.w_down = (const float*)d_in[11];
    p.out = (float*)d_out; p.ws = (unsigned char*)d_ws;
#if ONE_LAUNCH
    p.ph_lo = 0; p.ph_hi = 16;
    void* args[] = {&p};
    hipError_t e = hipLaunchCooperativeKernel((const void*)mega_fwd, dim3(grid), dim3(512), args, LDS_BYTES, stream);
    if (e != hipSuccess) fprintf(stderr, "cooperative launch failed: %s (grid %d)\n", hipGetErrorString(e), grid);
#else
    for (int ph = 0; ph < 16; ++ph) {
        p.ph_lo = ph; p.ph_hi = ph + 1;
        hipLaunchKernelGGL(mega_fwd, dim3(grid), dim3(512), LDS_BYTES, stream, p);
    }
#endif
}
```
